# Optimizing an MI355X kernel written in HIP

```python
import math
import jax, jax.numpy as jnp
from jax import lax
import numpy as np

D_MODEL = 2048
BATCH = 2
SEQ = 4096
DEPTH = 1

N_META = 16
Q_BLOCK = 128
MLA_HEADS = 8
MLA_NOPE = 128
MLA_ROPE = 64
MLA_V = 128
Q_LORA = 512
KV_LORA = 256
ROPE_THETA = 10000.0
DIFF_HEADS = 4
DIFF_DK = 128
DIFF_V = 2 * DIFF_DK
DIFF_QK = DIFF_HEADS * 2 * DIFF_DK
D_MIX = MLA_HEADS * MLA_V + DIFF_HEADS * DIFF_V
NUM_BUCKETS = 32
REL_MAX_DIST = 128
N_BIAS_MAPS = 2 * DIFF_HEADS
D_FF = 5632
CONV_W = 3
EPS = 1e-6
IN_SPLITS = (Q_LORA, KV_LORA, MLA_ROPE, DIFF_QK, DIFF_QK, DIFF_HEADS * DIFF_V)
D_IN = sum(IN_SPLITS)

kernel_name = "hymba_mla_diffattn_convffn_layer"


def rmsnorm(x, g):
    xf = x.astype(jnp.float32)
    y = xf * lax.rsqrt(jnp.mean(xf * xf, axis=-1, keepdims=True) + EPS)
    return (y * g.astype(jnp.float32)).astype(x.dtype)


def rope(x, pos):
    half = x.shape[-1] // 2
    inv = ROPE_THETA ** (-jnp.arange(half, dtype=jnp.float32) / half)
    ang = pos.astype(jnp.float32)[:, None] * inv[None, :]
    shp = (1, pos.shape[0]) + (1,) * (x.ndim - 3) + (half,)
    cos, sin = jnp.cos(ang).reshape(shp), jnp.sin(ang).reshape(shp)
    xf = x.astype(jnp.float32)
    x1, x2 = xf[..., :half], xf[..., half:]
    return jnp.concatenate([x1 * cos - x2 * sin, x2 * cos + x1 * sin], axis=-1).astype(x.dtype)


def t5_bucket(rel):
    n = jnp.maximum(rel, 0)
    max_exact = NUM_BUCKETS // 2
    nf = jnp.maximum(n, 1).astype(jnp.float32)
    large = max_exact + (jnp.log(nf / max_exact) / math.log(REL_MAX_DIST / max_exact)
                         * (NUM_BUCKETS - max_exact)).astype(jnp.int32)
    large = jnp.minimum(large, NUM_BUCKETS - 1)
    return jnp.where(n < max_exact, n, large)


def token_mixer(n, pos, rel_bias, w_in, w_uq, w_ukv, w_o, g_cq, g_ckv,
                lq1, lk1, lq2, lk2, g_sub, layer_idx):
    B, Lp, _ = n.shape
    nb = Lp // Q_BLOCK
    proj = n @ w_in
    cuts = list(np.cumsum(IN_SPLITS)[:-1])
    c_q, c_kv, k_r, q_d, k_d, v_d = jnp.split(proj, cuts, axis=-1)

    c_q = rmsnorm(c_q, g_cq)
    c_kv = rmsnorm(c_kv, g_ckv)
    q_m = (c_q @ w_uq).reshape(B, Lp, MLA_HEADS, MLA_NOPE + MLA_ROPE)
    q_nope = q_m[..., :MLA_NOPE]
    q_rope = rope(q_m[..., MLA_NOPE:], pos)
    kv = (c_kv @ w_ukv).reshape(B, Lp, MLA_HEADS, MLA_NOPE + MLA_V)
    k_nope = kv[..., :MLA_NOPE].transpose(0, 2, 1, 3)
    v_m = kv[..., MLA_NOPE:].transpose(0, 2, 1, 3)
    k_rope = rope(k_r, pos)
    mla_scale = 1.0 / math.sqrt(MLA_NOPE + MLA_ROPE)

    q_d = q_d.reshape(B, Lp, DIFF_HEADS, 2, DIFF_DK)
    k_d = k_d.reshape(B, Lp, DIFF_HEADS, 2, DIFF_DK).transpose(0, 2, 3, 1, 4)
    v_d = v_d.reshape(B, Lp, DIFF_HEADS, DIFF_V).transpose(0, 2, 1, 3)
    lam_init = 0.8 - 0.6 * math.exp(-0.3 * layer_idx)
    lam = (jnp.exp(jnp.sum(lq1.astype(jnp.float32) * lk1.astype(jnp.float32)))
           - jnp.exp(jnp.sum(lq2.astype(jnp.float32) * lk2.astype(jnp.float32))) + lam_init)
    diff_scale = 1.0 / math.sqrt(DIFF_DK)

    qn_b = q_nope.reshape(B, nb, Q_BLOCK, MLA_HEADS, MLA_NOPE).transpose(1, 0, 3, 2, 4)
    qr_b = q_rope.reshape(B, nb, Q_BLOCK, MLA_HEADS, MLA_ROPE).transpose(1, 0, 3, 2, 4)
    qd_b = q_d.reshape(B, nb, Q_BLOCK, DIFF_HEADS, 2, DIFF_DK).transpose(1, 0, 3, 4, 2, 5)
    q_start = jnp.arange(nb, dtype=jnp.int32) * Q_BLOCK
    kpos = jnp.arange(Lp, dtype=jnp.int32)
    rel_bias_f = rel_bias.astype(jnp.float32)

    def attend(args):
        qn, qr, qd, q0 = args
        qpos = q0 + jnp.arange(Q_BLOCK, dtype=jnp.int32)
        rel = qpos[:, None] - kpos[None, :]
        causal = rel >= 0
        s_m = (jnp.einsum('bhqd,bhkd->bhqk', qn, k_nope)
               + jnp.einsum('bhqr,bkr->bhqk', qr, k_rope)).astype(jnp.float32) * mla_scale
        p_m = jax.nn.softmax(jnp.where(causal, s_m, -jnp.inf), axis=-1)
        o_m = jnp.einsum('bhqk,bhkd->bqhd', p_m.astype(v_m.dtype), v_m)
        bias = rel_bias_f[t5_bucket(rel)]
        bias = bias.reshape(Q_BLOCK, Lp, DIFF_HEADS, 2).transpose(2, 3, 0, 1)
        s_d = jnp.einsum('bhcqd,bhckd->bhcqk', qd, k_d).astype(jnp.float32) * diff_scale + bias
        p_d = jax.nn.softmax(jnp.where(causal, s_d, -jnp.inf), axis=-1)
        a = p_d[:, :, 0] - lam * p_d[:, :, 1]
        o_d = jnp.einsum('bhqk,bhkd->bqhd', a.astype(v_d.dtype), v_d)
        return o_m, o_d

    o_m, o_d = lax.map(attend, (qn_b, qr_b, qd_b, q_start))
    o_m = o_m.transpose(1, 0, 2, 3, 4).reshape(B, Lp, MLA_HEADS * MLA_V)
    o_d = o_d.transpose(1, 0, 2, 3, 4).reshape(B, Lp, DIFF_HEADS, DIFF_V)
    o_d = (rmsnorm(o_d, g_sub) * (1.0 - lam_init)).reshape(B, Lp, DIFF_HEADS * DIFF_V)
    return jnp.concatenate([o_m, o_d], axis=-1) @ w_o


def conv_gated_mlp(n, w_up, conv_w, conv_b, w_down):
    Lp = n.shape[1]
    up = n @ w_up
    upp = jnp.pad(up, ((0, 0), (CONV_W - 1, 0), (0, 0)))
    conv = conv_b
    for j in range(CONV_W):
        conv = conv + conv_w[j] * upp[:, j:j + Lp]
    gate, val = jnp.split(conv, 2, axis=-1)
    return (jax.nn.silu(gate) * val) @ w_down


def setup_inputs(seed: int = 0) -> dict:
    key = jax.random.key(seed)
    ks = jax.random.split(key, 24)
    f32 = jnp.float32
    nrm = lambda k, shp, s: jax.random.normal(k, shp, f32) * s
    gain = lambda k, shp: 1.0 + 0.05 * jax.random.normal(k, shp, f32)
    L = DEPTH
    return {
        "x": nrm(ks[0], (BATCH, SEQ, D_MODEL), 1.0),
        "meta_tokens": nrm(ks[1], (N_META, D_MODEL), 1.0),
        "rel_bias": nrm(ks[2], (NUM_BUCKETS, N_BIAS_MAPS), 0.5),
        "w_in": nrm(ks[3], (L, D_MODEL, D_IN), D_MODEL ** -0.5),
        "w_uq": nrm(ks[4], (L, Q_LORA, MLA_HEADS * (MLA_NOPE + MLA_ROPE)), Q_LORA ** -0.5),
        "w_ukv": nrm(ks[5], (L, KV_LORA, MLA_HEADS * (MLA_NOPE + MLA_V)), KV_LORA ** -0.5),
        "w_o": nrm(ks[6], (L, D_MIX, D_MODEL), D_MIX ** -0.5),
        "g_attn_pre": gain(ks[7], (L, D_MODEL)),
        "g_attn_post": gain(ks[8], (L, D_MODEL)),
        "g_cq": gain(ks[9], (L, Q_LORA)),
        "g_ckv": gain(ks[10], (L, KV_LORA)),
        "lambda_q1": nrm(ks[11], (L, DIFF_DK), 0.1),
        "lambda_k1": nrm(ks[12], (L, DIFF_DK), 0.1),
        "lambda_q2": nrm(ks[13], (L, DIFF_DK), 0.1),
        "lambda_k2": nrm(ks[14], (L, DIFF_DK), 0.1),
        "g_diff_sub": gain(ks[15], (L, DIFF_V)),
        "g_ffn_pre": gain(ks[16], (L, D_MODEL)),
        "g_ffn_post": gain(ks[17], (L, D_MODEL)),
        "w_up": nrm(ks[18], (L, D_MODEL, 2 * D_FF), D_MODEL ** -0.5),
        "conv_w": nrm(ks[19], (L, CONV_W, 2 * D_FF), CONV_W ** -0.5),
        "conv_b": nrm(ks[20], (L, 2 * D_FF), 0.01),
        "w_down": nrm(ks[21], (L, D_FF, D_MODEL), D_FF ** -0.5),
    }


def reference(x, meta_tokens, rel_bias, w_in, w_uq, w_ukv, w_o, g_attn_pre, g_attn_post,
              g_cq, g_ckv, lambda_q1, lambda_k1, lambda_q2, lambda_k2, g_diff_sub,
              g_ffn_pre, g_ffn_post, w_up, conv_w, conv_b, w_down):
    B, S, D = x.shape
    L = S + N_META
    Lp = ((L + Q_BLOCK - 1) // Q_BLOCK) * Q_BLOCK
    meta = jnp.broadcast_to(meta_tokens[None].astype(x.dtype), (B, N_META, D))
    pad = jnp.zeros((B, Lp - L, D), x.dtype)
    h = jnp.concatenate([meta, x, pad], axis=1)
    pos = jnp.arange(Lp, dtype=jnp.int32)
    for l in range(DEPTH):
        n = rmsnorm(h, g_attn_pre[l])
        a = token_mixer(n, pos, rel_bias, w_in[l], w_uq[l], w_ukv[l], w_o[l], g_cq[l], g_ckv[l],
                        lambda_q1[l], lambda_k1[l], lambda_q2[l], lambda_k2[l], g_diff_sub[l], l)
        h = h + rmsnorm(a, g_attn_post[l])
        n = rmsnorm(h, g_ffn_pre[l])
        f = conv_gated_mlp(n, w_up[l], conv_w[l], conv_b[l], w_down[l])
        h = h + rmsnorm(f, g_ffn_post[l])
    return h[:, N_META:N_META + S]
```

```cpp
#include <hip/hip_runtime.h>
#include <hip/hip_bf16.h>
#include <cstdio>
#include <cstdint>
#include <cmath>

#ifndef MK_ONE_LAUNCH
#define MK_ONE_LAUNCH 1
#endif
#ifndef DEBUG_CHECK
#define DEBUG_CHECK 0
#endif

#define LAS __attribute__((address_space(3)))
#define GAS __attribute__((address_space(1)))
typedef unsigned short bf16_t;
typedef short bf16x8 __attribute__((ext_vector_type(8)));
typedef short s16x4 __attribute__((ext_vector_type(4)));
typedef float f32x4 __attribute__((ext_vector_type(4)));
typedef float f32x2 __attribute__((ext_vector_type(2)));
typedef float f32x16 __attribute__((ext_vector_type(16)));
typedef unsigned u32x4 __attribute__((ext_vector_type(4)));
typedef unsigned u32x2 __attribute__((ext_vector_type(2)));

constexpr int DM = 2048, SEQ = 4096, NMETA = 16, LREAL = SEQ + NMETA  , LPB = 4352  ;
constexpr int MMAIN = 2 * SEQ  , MR = 8448  ;
constexpr int DIN = 3904, NP1 = 4096, DLAT = 1024;
constexpr int QL = 512, KVL = 256, NQM = 1536, NKV = 2048;
constexpr int DFF = 5632, NUP = 2 * DFF;
constexpr float EPS = 1e-6f;
constexpr float LOG2E = 1.4426950408889634f;
constexpr float MLA_QSCALE = 0.07216878364870322f * LOG2E;
constexpr float DIFF_QSCALE = 0.08838834764831845f * LOG2E;
constexpr float LAM_INIT = 0.2f;

constexpr size_t MiB = 1u << 20;
constexpr size_t WS_CTL = 0, CTL_ZERO_BYTES = 1 * MiB;
constexpr size_t WS_CS = 1 * MiB;
constexpr size_t WS_BT = 3 * MiB;
constexpr size_t WS_W1 = 4 * MiB;
constexpr size_t WS_WUQ = 20 * MiB;
constexpr size_t WS_WUKV = 22 * MiB;
constexpr size_t WS_WO = 23 * MiB;
constexpr size_t WS_WUP = 31 * MiB;
constexpr size_t WS_WDN = 75 * MiB;
constexpr size_t WS_A = 97 * MiB;
constexpr size_t WS_NR = WS_A + 0 * MiB;
constexpr size_t WS_LAT = WS_A + 33 * MiB;
constexpr size_t WS_CQN = WS_A + 50 * MiB;
constexpr size_t WS_CKVN = WS_A + 59 * MiB;
constexpr size_t WS_QD = WS_A + 64 * MiB;
constexpr size_t WS_KD = WS_A + 81 * MiB;
constexpr size_t WS_VD = WS_A + 98 * MiB;
constexpr size_t WS_QM = WS_A + 115 * MiB;
constexpr size_t WS_KM = WS_A + 141 * MiB;
constexpr size_t WS_VM = WS_A + 167 * MiB;
constexpr size_t WS_CAT = WS_A + 0 * MiB;
constexpr size_t WS_DP = WS_A + 184 * MiB;
constexpr size_t WS_AO = WS_A + 33 * MiB;
constexpr size_t WS_H = WS_A + 99 * MiB;
constexpr size_t WS_N2 = WS_A + 165 * MiB;
constexpr size_t WS_ACT = WS_A + 0 * MiB;
constexpr size_t WS_F = WS_A + 165 * MiB;
constexpr size_t WS_END = WS_A + 250 * MiB;
constexpr size_t WS_CHK = 512 * 1024;
constexpr int CW_BAR = 4096;
constexpr int CW_QUEUE = 16384;

constexpr int RING_BYTES = 131072, LDSCTL_OFF = RING_BYTES, MISC_OFF = LDSCTL_OFF + 320, XCONV_OFF = 133120, LDS_BYTES = 147456;

#define RLX_AGENT __ATOMIC_RELAXED, __HIP_MEMORY_SCOPE_AGENT
#define LDS_WAIT() asm volatile("s_waitcnt lgkmcnt(0)" ::: "memory")
#define VM_WAIT() asm volatile("s_waitcnt vmcnt(0)" ::: "memory")
__host__ __device__ __forceinline__ unsigned f2bf(float f) { unsigned u = __builtin_bit_cast(unsigned, f); return (u + 0x7fffu + ((u >> 16) & 1u)) >> 16; }
__host__ __device__ __forceinline__ float bf2f(unsigned h) { return __builtin_bit_cast(float, (h & 0xffffu) << 16); }
__device__ __forceinline__ unsigned pk2(float lo, float hi) { return f2bf(lo) | (f2bf(hi) << 16); }
__device__ __forceinline__ unsigned cvt_pk_bf16(float lo, float hi) { unsigned r; asm volatile("v_cvt_pk_bf16_f32 %0, %1, %2" : "=v"(r) : "v"(lo), "v"(hi)); return r; }
__device__ __forceinline__ float wave_sum(float v) {
#pragma unroll
    for (int o = 1; o < 64; o <<= 1) v += __shfl_xor(v, o);
    return v;
}
__device__ __forceinline__ float wave_max(float v) {
#pragma unroll
    for (int o = 1; o < 64; o <<= 1) v = fmaxf(v, __shfl_xor(v, o));
    return v;
}
__device__ __forceinline__ int row_dests(int pm, int lr, int& b0, int& pos) {
    if (pm < 32) { b0 = pm >> 4; pos = NMETA + (pm & 15) * 256 + lr; return 1; }
    b0 = 0; pos = lr; return (pm == 32 && lr < NMETA) ? 2 : 0;
}
__host__ __device__ __forceinline__ int map_win(int n) { if (n < 768) return n; if (n < 832) { const int i = n - 768; return 768 + 2 * (i & 31) + (i >> 5); } return n + 192; }
__host__ __device__ __forceinline__ int map_wuq(int n) { const int h = n / 192, d = n - 192 * h; if (d < 128) return n; const int i = d - 128; return h * 192 + 128 + 2 * (i & 31) + (i >> 5); }
__host__ __device__ __forceinline__ int map_wup(int n) { if (n < DFF) return (n >> 7) * 256 + (n & 127); const int m = n - DFF; return (m >> 7) * 256 + 128 + (m & 127); }

namespace pg8 {
constexpr int BM = 256, BK = 64, HALF = 128, HTB = HALF * BK * 2, STAGE_BYTES = 8 * HTB, NXCD = 8, WGM = 8;
__host__ __device__ __forceinline__ int lds_byte(int r, int c) { const int st = (r >> 4) * 2 + (c >> 5), rr = r & 15, cc = c & 31, ob = rr * 64 + cc * 2; return st * 1024 + (ob ^ (((ob >> 9) & 1) << 5)); }
__host__ __device__ __forceinline__ void stage_rc(int b, int& R, int& C) { const int st = b / 1024, sb = b % 1024, swz = sb ^ (((sb >> 9) & 1) << 5); R = (st >> 1) * 16 + swz / 64; C = (st & 1) * 32 + (swz % 64) / 2; }
__host__ __device__ __forceinline__ int perm32(int rho) { const int n = rho >> 4, i = rho & 15; return 8 * (i >> 2) + 4 * n + (i & 3); }

struct Unit { int pm, pn, arow; };
struct Gemm { const bf16_t* A; const bf16_t* Bt; int lda; int K; };

template <int MODE> struct StaticOrder {
    int nM, nN, nwg, G, c;
    __device__ void init(int nM_, int nN_, int G_, int c_) { nM = nM_; nN = nN_; nwg = nM * nN; G = G_; c = c_; }
    __device__ bool next(int i, Unit& u) const {
        const long L = (long)i * G + c; if (L >= nwg) return false;
        int wgid = (int)L; { const int q = nwg / NXCD, r = nwg % NXCD, xcd = wgid % NXCD, off = wgid / NXCD; wgid = (xcd < r ? xcd * (q + 1) : r * (q + 1) + (xcd - r) * q) + off; }
        const int nig = WGM * nN, gid = wgid / nig, fm = gid * WGM, gsz = (nM - fm) < WGM ? (nM - fm) : WGM;
        u.pm = fm + ((wgid % nig) % gsz); u.pn = (wgid % nig) / gsz;
        if (MODE == 0) u.arow = u.pm * BM; else { const int b = u.pm / 17, i2 = u.pm - 17 * b; u.arow = b * LPB + 14 + 254 * i2; }
        return true;
    }
};

__device__ __forceinline__ u32x4 pack8(const f32x4 v0, const f32x4 v1) { u32x4 w; w.x = cvt_pk_bf16(v0[0], v0[1]); w.y = cvt_pk_bf16(v0[2], v0[3]); w.z = cvt_pk_bf16(v1[0], v1[1]); w.w = cvt_pk_bf16(v1[2], v1[3]); return w; }

struct EpiG1 {
    static constexpr bool PERM = true;
    bf16_t* lat; bf16_t* qd; bf16_t* kd; bf16_t* vd; float qscale;
    __device__ __forceinline__ void operator()(f32x4 (&acc)[2][2][4][2], const Unit& u, int wr, int wc, int fr_in, int fq) const {
        int fr = fr_in; asm volatile("" : "+v"(fr));
        const int colin = wc * 32 + 8 * fq;
#pragma unroll
        for (int bj = 0; bj < 2; ++bj) {
            const int q = 2 * u.pn + bj; float sc = 1.f; bf16_t* base;
            if (q < 8) base = lat + 128 * q + colin;
            else if (q < 16) { base = qd + (size_t)(q - 8) * LPB * 128 + colin; sc = qscale; }
            else if (q < 24) base = kd + (size_t)(q - 16) * LPB * 128 + colin;
            else base = vd + (size_t)(q - 24) * LPB * 128 + colin;
#pragma unroll
            for (int ai = 0; ai < 2; ++ai)
#pragma unroll
                for (int m = 0; m < 4; ++m) {
                    const int lr = ai * HALF + wr * 64 + m * 16 + fr;
                    const u32x4 w = pack8(acc[ai][bj][m][0] * sc, acc[ai][bj][m][1] * sc);
                    if (q < 8) { *(u32x4*)(base + (size_t)(u.pm * BM + lr) * DLAT) = w; }
                    else { int b0, pos; const int nb = row_dests(u.pm, lr, b0, pos);
                        for (int k = 0; k < nb; ++k) *(u32x4*)(base + ((size_t)(b0 + k) * 8 * LPB + pos) * 128) = w; }
                }
        }
    }
};
struct EpiQm {
    static constexpr bool PERM = true;
    bf16_t* qm; const float* cs; float qscale;
    __device__ __forceinline__ void operator()(f32x4 (&acc)[2][2][4][2], const Unit& u, int wr, int wc, int fr_in, int fq) const {
        int fr = fr_in; asm volatile("" : "+v"(fr));
#pragma unroll
        for (int bj = 0; bj < 2; ++bj) {
            const int c0 = u.pn * BM + bj * HALF + wc * 32 + 8 * fq, h = c0 / 192, d = c0 - 192 * h; const bool rope = d >= 128; const int i0 = (d - 128) >> 1;
#pragma unroll
            for (int ai = 0; ai < 2; ++ai)
#pragma unroll
                for (int m = 0; m < 4; ++m) {
                    const int lr = ai * HALF + wr * 64 + m * 16 + fr; int b0, pos; const int nb = row_dests(u.pm, lr, b0, pos);
                    f32x4 v0 = acc[ai][bj][m][0], v1 = acc[ai][bj][m][1];
                    if (rope && nb) { const f32x4 t0 = *(const f32x4*)(cs + ((size_t)pos * 32 + i0) * 2), t1 = *(const f32x4*)(cs + ((size_t)pos * 32 + i0 + 2) * 2);
                        const f32x4 a0 = v0, a1 = v1;
                        v0[0] = a0[0] * t0[0] - a0[1] * t0[1]; v0[1] = a0[1] * t0[0] + a0[0] * t0[1]; v0[2] = a0[2] * t0[2] - a0[3] * t0[3]; v0[3] = a0[3] * t0[2] + a0[2] * t0[3];
                        v1[0] = a1[0] * t1[0] - a1[1] * t1[1]; v1[1] = a1[1] * t1[0] + a1[0] * t1[1]; v1[2] = a1[2] * t1[2] - a1[3] * t1[3]; v1[3] = a1[3] * t1[2] + a1[2] * t1[3]; }
                    const u32x4 w = pack8(v0 * qscale, v1 * qscale);
                    for (int k = 0; k < nb; ++k) *(u32x4*)(qm + ((size_t)((b0 + k) * 8 + h) * LPB + pos) * 192 + d) = w;
                    asm volatile("" ::: "memory");
                }
        }
    }
};
struct EpiKv {
    static constexpr bool PERM = true;
    bf16_t* km; bf16_t* vm;
    __device__ __forceinline__ void operator()(f32x4 (&acc)[2][2][4][2], const Unit& u, int wr, int wc, int fr_in, int fq) const {
        int fr = fr_in; asm volatile("" : "+v"(fr));
        const int colin = wc * 32 + 8 * fq, h = u.pn;
#pragma unroll
        for (int ai = 0; ai < 2; ++ai)
#pragma unroll
            for (int m = 0; m < 4; ++m) {
                const int lr = ai * HALF + wr * 64 + m * 16 + fr; int b0, pos; const int nb = row_dests(u.pm, lr, b0, pos);
                const u32x4 w0 = pack8(acc[ai][0][m][0], acc[ai][0][m][1]), w1 = pack8(acc[ai][1][m][0], acc[ai][1][m][1]);
                for (int k = 0; k < nb; ++k) { const unsigned row = (unsigned)((b0 + k) * 8 + h) * LPB + pos;
                    *(u32x4*)(km + (size_t)row * 192 + colin) = w0; *(u32x4*)(vm + (size_t)row * 128 + colin) = w1; }
                asm volatile("" ::: "memory");
            }
    }
};
struct EpiF32 {
    static constexpr bool PERM = false;
    float* out; int ldc;
    __device__ __forceinline__ void operator()(f32x4 (&acc)[2][2][4][2], const Unit& u, int wr, int wc, int fr_in, int fq) const {
        int fr = fr_in; asm volatile("" : "+v"(fr));
        const int col0 = u.pn * BM + wc * 32 + 4 * fq;
#pragma unroll
        for (int ai = 0; ai < 2; ++ai)
#pragma unroll
            for (int m = 0; m < 4; ++m) { float* rowp = out + (size_t)(u.pm * BM + ai * HALF + wr * 64 + m * 16 + fr) * ldc + col0;
#pragma unroll
                for (int bj = 0; bj < 2; ++bj)
#pragma unroll
                    for (int n = 0; n < 2; ++n) *(f32x4*)(rowp + bj * HALF + n * 16) = acc[ai][bj][m][n]; }
    }
};
struct EpiConv {
    static constexpr bool PERM = true;
    bf16_t* act; const float* cw; const float* cb; LAS float* X;
    __device__ __forceinline__ void operator()(f32x4 (&acc)[2][2][4][2], const Unit& u, int wr, int wc, int fr_in, int fq) const {
        int fr = fr_in; asm volatile("" : "+v"(fr));
        const int lane = threadIdx.x & 63, colx = wc * 32 + 8 * fq;
        const int src1 = (lane & ~15) | ((fr - 1) & 15), src2 = (lane & ~15) | ((fr - 2) & 15);
        if (fr >= 14) {
#pragma unroll
            for (int ai = 0; ai < 2; ++ai)
#pragma unroll
                for (int bj = 0; bj < 2; ++bj)
#pragma unroll
                    for (int n = 0; n < 2; ++n) *(LAS f32x4*)(X + (((2 * ai + wr) * 2 + (fr - 14)) * 256 + bj * HALF + colx + 4 * n)) = acc[ai][bj][3][n];
        }
        asm volatile("s_waitcnt lgkmcnt(0)" ::: "memory"); __builtin_amdgcn_s_barrier(); asm volatile("" ::: "memory");
#pragma unroll
        for (int bj = 0; bj < 2; ++bj)
#pragma unroll
            for (int n = 0; n < 2; ++n) {
                const int gcol = (bj ? DFF : 0) + u.pn * HALF + colx + 4 * n;
                const f32x4 w0 = *(const f32x4*)(cw + gcol), w1 = *(const f32x4*)(cw + NUP + gcol), w2 = *(const f32x4*)(cw + 2 * NUP + gcol), bb = *(const f32x4*)(cb + gcol);
#pragma unroll
                for (int ai = 0; ai < 2; ++ai) {
                    const int g = 2 * ai + wr;
                    f32x4 x62 = (f32x4){0.f, 0.f, 0.f, 0.f}, x63 = x62;
                    if (g > 0) { x62 = *(const LAS f32x4*)(X + (((g - 1) * 2 + 0) * 256 + bj * HALF + colx + 4 * n)); x63 = *(const LAS f32x4*)(X + (((g - 1) * 2 + 1) * 256 + bj * HALF + colx + 4 * n)); }
                    f32x4 s1, s2;
#pragma unroll
                    for (int e = 0; e < 4; ++e) { s1[e] = __shfl(acc[ai][bj][3][n][e], src1); s2[e] = __shfl(acc[ai][bj][3][n][e], src2); }
#pragma unroll
                    for (int m = 3; m >= 0; --m) {
                        f32x4 q1, q2;
                        if (m > 0) {
#pragma unroll
                            for (int e = 0; e < 4; ++e) { q1[e] = __shfl(acc[ai][bj][m - 1][n][e], src1); q2[e] = __shfl(acc[ai][bj][m - 1][n][e], src2); }
                        } else { q1 = x63; q2 = (fr == 0) ? x62 : x63; }
                        const f32x4 cur = acc[ai][bj][m][n]; f32x4 nw;
#pragma unroll
                        for (int e = 0; e < 4; ++e) { const float p1 = (fr == 0) ? q1[e] : s1[e], p2 = (fr < 2) ? q2[e] : s2[e]; nw[e] = bb[e] + w0[e] * p2 + w1[e] * p1 + w2[e] * cur[e]; }
                        asm volatile("" : "+v"(nw[0]), "+v"(nw[1]), "+v"(nw[2]), "+v"(nw[3]));
                        acc[ai][bj][m][n] = nw; s1 = q1; s2 = q2;
                    }
                    asm volatile("" ::: "memory");
                }
                __builtin_amdgcn_sched_barrier(0);
            }
        const int b = u.pm / 17, i2 = u.pm - 17 * b, p0 = 14 + 254 * i2;
#pragma unroll
        for (int ai = 0; ai < 2; ++ai)
#pragma unroll
            for (int m = 0; m < 4; ++m) {
                const int lr = ai * HALF + wr * 64 + m * 16 + fr, pos = p0 + lr;
                f32x4 o0, o1;
#pragma unroll
                for (int e = 0; e < 4; ++e) { const float g0 = acc[ai][0][m][0][e], g1 = acc[ai][0][m][1][e];
                    o0[e] = g0 * __builtin_amdgcn_rcpf(1.f + __builtin_amdgcn_exp2f(-g0 * LOG2E)) * acc[ai][1][m][0][e];
                    o1[e] = g1 * __builtin_amdgcn_rcpf(1.f + __builtin_amdgcn_exp2f(-g1 * LOG2E)) * acc[ai][1][m][1][e]; }
                if (lr >= 2 && pos < LREAL) *(u32x4*)(act + (size_t)(b * SEQ + pos - NMETA) * DFF + u.pn * HALF + colx) = pack8(o0, o1);
                asm volatile("" ::: "memory");
            }
    }
};

template <class Epi, class Sched, bool ALIGN_EPI>
__device__ __forceinline__ void gemm_phase(LAS unsigned char* lds, const Gemm g, const Sched& S, const Epi& E) {
    int tid_ = threadIdx.x; asm volatile("" : "+v"(tid_));
    const int tid = tid_, wid = __builtin_amdgcn_readfirstlane(tid >> 6), lane = tid & 63, wr = wid >> 2, wc = wid & 3, fr = lane & 15, fq = lane >> 4;
    const int K = g.K, nt = K / BK, lda = g.lda;
    unsigned voffA[2], voffB[2];
#pragma unroll
    for (int i = 0; i < 2; ++i) { int R, C; stage_rc(tid * 16 + i * 8192, R, C); const int Rb = Epi::PERM ? ((R & ~31) + perm32(R & 31)) : R;
        voffA[i] = (unsigned)(R * lda + C) * 2u; voffB[i] = (unsigned)(Rb * K + C) * 2u; }
    const size_t kstep = (size_t)(BK * 2);
    const size_t hstepA = (size_t)HALF * lda * 2, hstepB = (size_t)HALF * K * 2;
    const size_t tstepB = 2 * hstepB;
    const unsigned ldsw = (unsigned)wid * 1024u;
    const int aoff = lds_byte(wr * 64 + fr, fq * 8), boff = lds_byte(wc * 32 + fr, fq * 8);
#define PG8_SA(b, h) (((b) * 2 + (h)) * HTB)
#define PG8_SB(b, h) ((4 + (b) * 2 + (h)) * HTB)
#define PG8_STAGE(bufoff, gbase, voff) do { _Pragma("unroll") for (int _i = 0; _i < 2; ++_i) \
        __builtin_amdgcn_global_load_lds((const unsigned*)((const char*)(gbase) + (voff)[_i]), (LAS unsigned*)(lds + (bufoff) + ldsw + _i * 8192), 16, 0, 0); } while (0)
#define PG8_LDA(dst, b, h) do { _Pragma("unroll") for (int m = 0; m < 4; ++m) _Pragma("unroll") for (int k = 0; k < 2; ++k) dst[m][k] = *(const LAS bf16x8*)(lds + PG8_SA(b, h) + aoff + m * 2048 + k * 1024); } while (0)
#define PG8_LDB(dst, b, h) do { _Pragma("unroll") for (int n = 0; n < 2; ++n) _Pragma("unroll") for (int k = 0; k < 2; ++k) dst[n][k] = *(const LAS bf16x8*)(lds + PG8_SB(b, h) + boff + n * 2048 + k * 1024); } while (0)
#define PG8_MMA(ai, bj, At, Bt) do { __builtin_amdgcn_s_setprio(1); _Pragma("unroll") for (int m = 0; m < 4; ++m) _Pragma("unroll") for (int n = 0; n < 2; ++n) _Pragma("unroll") for (int k = 0; k < 2; ++k) \
        acc[ai][bj][m][n] = __builtin_amdgcn_mfma_f32_16x16x32_bf16(Bt[n][k], At[m][k], acc[ai][bj][m][n], 0, 0, 0); __builtin_amdgcn_s_setprio(0); } while (0)
#define PG8_WAIT_V(n) asm volatile("s_waitcnt vmcnt(" #n ")" ::: "memory")
#define PG8_WAIT_L(n) asm volatile("s_waitcnt lgkmcnt(" #n ")" ::: "memory")
#define PG8_BAR __builtin_amdgcn_s_barrier()
#define PG8_SCHED __builtin_amdgcn_sched_barrier(0)
    Unit cur, nxt; int ui = 0;
    if (!S.next(0, cur)) return;
    f32x4 acc[2][2][4][2];
#pragma unroll
    for (int a = 0; a < 2; ++a)
#pragma unroll
        for (int b = 0; b < 2; ++b)
#pragma unroll
            for (int m = 0; m < 4; ++m)
#pragma unroll
                for (int n = 0; n < 2; ++n) acc[a][b][m][n] = (f32x4){0.f, 0.f, 0.f, 0.f};
    bf16x8 At[4][2], B0[2][2], B1[2][2];
    const char* cA = (const char*)g.A + (size_t)cur.arow * lda * 2; const char* cB = (const char*)g.Bt + (size_t)cur.pn * tstepB;
    PG8_STAGE(PG8_SB(0, 0), cB, voffB); PG8_STAGE(PG8_SB(0, 1), cB + hstepB, voffB); PG8_STAGE(PG8_SA(0, 0), cA, voffA); PG8_STAGE(PG8_SA(0, 1), cA + hstepA, voffA);
    if (wr == 1) PG8_BAR;
    PG8_WAIT_V(2); PG8_BAR;
    PG8_STAGE(PG8_SB(1, 0), cB + kstep, voffB); PG8_STAGE(PG8_SA(1, 0), cA + kstep, voffA); PG8_STAGE(PG8_SB(1, 1), cB + hstepB + kstep, voffB);
    PG8_WAIT_V(6); PG8_BAR;
    for (;;) {
        const bool has_next = S.next(ui + 1, nxt);
        const char* nA = has_next ? (const char*)g.A + (size_t)nxt.arow * lda * 2 : cA; const char* nB = has_next ? (const char*)g.Bt + (size_t)nxt.pn * tstepB : cB;
        for (int t = 0; t < nt; t += 2) {
            const bool last = (t == nt - 2);
            const char* a1 = cA + (size_t)(t + 1) * kstep;
            const char* a2 = last ? nA : cA + (size_t)(t + 2) * kstep; const char* b2 = last ? nB : cB + (size_t)(t + 2) * kstep;
            const char* a3 = a2 + kstep; const char* b3 = b2 + kstep;
            PG8_LDB(B0, 0, 0); PG8_LDB(B1, 0, 1); PG8_SCHED; PG8_LDA(At, 0, 0); PG8_STAGE(PG8_SA(1, 1), a1 + hstepA, voffA);
            PG8_WAIT_V(8); PG8_WAIT_L(0); PG8_BAR; PG8_MMA(0, 0, At, B0); PG8_MMA(0, 1, At, B1); PG8_BAR; PG8_SCHED;
            PG8_LDA(At, 0, 1); PG8_STAGE(PG8_SB(0, 0), b2, voffB); PG8_STAGE(PG8_SB(0, 1), b2 + hstepB, voffB); PG8_STAGE(PG8_SA(0, 0), a2, voffA);
            PG8_WAIT_V(8); PG8_WAIT_L(0); PG8_BAR; PG8_MMA(1, 0, At, B0); PG8_MMA(1, 1, At, B1); PG8_BAR; PG8_SCHED;
            PG8_LDB(B0, 1, 0); PG8_LDB(B1, 1, 1); PG8_SCHED; PG8_LDA(At, 1, 0); PG8_STAGE(PG8_SA(0, 1), a2 + hstepA, voffA);
            PG8_WAIT_V(8); PG8_WAIT_L(0); PG8_BAR; PG8_MMA(0, 0, At, B0); PG8_MMA(0, 1, At, B1); PG8_BAR; PG8_SCHED;
            PG8_LDA(At, 1, 1); PG8_STAGE(PG8_SB(1, 0), b3, voffB); PG8_STAGE(PG8_SB(1, 1), b3 + hstepB, voffB); PG8_STAGE(PG8_SA(1, 0), a3, voffA);
            PG8_WAIT_V(8); PG8_WAIT_L(0); PG8_BAR; PG8_MMA(1, 0, At, B0); PG8_MMA(1, 1, At, B1); PG8_BAR; PG8_SCHED;
        }
        if constexpr (ALIGN_EPI) { if (wr == 0) PG8_BAR; }
        E(acc, cur, wr, wc, fr, fq);
        if (!has_next) break;
#pragma unroll
        for (int a = 0; a < 2; ++a)
#pragma unroll
            for (int b = 0; b < 2; ++b)
#pragma unroll
                for (int m = 0; m < 4; ++m)
#pragma unroll
                    for (int n = 0; n < 2; ++n) acc[a][b][m][n] = (f32x4){0.f, 0.f, 0.f, 0.f};
        cur = nxt; cA = nA; cB = nB; ++ui;
        if constexpr (ALIGN_EPI) { if (wr == 1) PG8_BAR; }
    }
    PG8_WAIT_V(0);
    if constexpr (!ALIGN_EPI) { if (wr == 0) PG8_BAR; }
    PG8_BAR;
#undef PG8_SA
#undef PG8_SB
#undef PG8_STAGE
#undef PG8_LDA
#undef PG8_LDB
#undef PG8_MMA
#undef PG8_WAIT_V
#undef PG8_WAIT_L
#undef PG8_BAR
#undef PG8_SCHED
}
}

namespace att {
constexpr int NW = 8, QBLK = 32, KVBLK = 64, DV = 128;
constexpr int SHM_V = KVBLK * DV * 2;
constexpr int OFF_V = 0, OFF_K = 2 * SHM_V, OFF_WS = OFF_K + 2 * KVBLK * 192 * 2  , OFF_BT = OFF_WS + NW * 64 * 4  , OFF_U = OFF_BT + 1024, OFF_QR = OFF_U + 1024, ATT_LDS = OFF_QR + NW * 4096;
constexpr float THR = 8.f;
#define SBAR() __builtin_amdgcn_sched_barrier(0)
__device__ __forceinline__ int crow(int r, int hi) { return (r & 3) + 8 * (r >> 2) + 4 * hi; }
template <int DQK> __device__ __forceinline__ int kswz(int row) { return DQK == 128 ? (row & 7) : ((row >> 1) & 7); }

__device__ __forceinline__ void partialSM(f32x16& p0, f32x16& p1, float& m_reg, float& alpha) {
    float pmax = p0[0];
#pragma unroll
    for (int r = 1; r < 16; ++r) pmax = fmaxf(pmax, p0[r]);
#pragma unroll
    for (int r = 0; r < 16; ++r) pmax = fmaxf(pmax, p1[r]);
    { auto rr = __builtin_amdgcn_permlane32_swap(__float_as_uint(pmax), __float_as_uint(pmax), false, false);
      pmax = fmaxf(__uint_as_float(rr[0]), __uint_as_float(rr[1])); }
    float mn;
    if (__builtin_expect(__all(pmax - m_reg <= THR), 1)) { mn = m_reg; alpha = 1.f; }
    else { mn = fmaxf(m_reg, pmax); alpha = __builtin_amdgcn_exp2f(m_reg - mn); m_reg = mn; }
#pragma unroll
    for (int r = 0; r < 16; ++r) p0[r] = p0[r] - mn;
#pragma unroll
    for (int r = 0; r < 16; ++r) p1[r] = p1[r] - mn;
#pragma unroll
    for (int r = 0; r < 16; ++r) p0[r] = __builtin_amdgcn_exp2f(p0[r]);
}
__device__ __forceinline__ void finishSM(f32x16& p0, f32x16& p1, float alpha, float& l_reg, bf16x8& pa0, bf16x8& pa1, bf16x8& pa2, bf16x8& pa3) {
#pragma unroll
    for (int r = 0; r < 16; ++r) p1[r] = __builtin_amdgcn_exp2f(p1[r]);
    float ps = 0;
#pragma unroll
    for (int r = 0; r < 16; ++r) ps += p0[r];
#pragma unroll
    for (int r = 0; r < 16; ++r) ps += p1[r];
    { auto rr = __builtin_amdgcn_permlane32_swap(__float_as_uint(ps), __float_as_uint(ps), false, false);
      ps = __uint_as_float(rr[0]) + __uint_as_float(rr[1]); }
    l_reg = l_reg * alpha + ps;
#define PK4(P, BASE, OUT) do { unsigned a0 = cvt_pk_bf16(P[BASE + 0], P[BASE + 1]), a1 = cvt_pk_bf16(P[BASE + 2], P[BASE + 3]);   \
    unsigned b0 = cvt_pk_bf16(P[BASE + 4], P[BASE + 5]), b1 = cvt_pk_bf16(P[BASE + 6], P[BASE + 7]);                              \
    auto r0 = __builtin_amdgcn_permlane32_swap(a0, b0, false, false); auto r1 = __builtin_amdgcn_permlane32_swap(a1, b1, false, false); \
    u32x4 w = {r0[0], r1[0], r0[1], r1[1]}; OUT = __builtin_bit_cast(bf16x8, w); } while (0)
    PK4(p0, 0, pa0); PK4(p0, 8, pa1); PK4(p1, 0, pa2); PK4(p1, 8, pa3);
#undef PK4
}
template <int DQK> __device__ __forceinline__ void qkt(f32x16& p0, f32x16& p1, const LAS char* Ks, const bf16x8* qr, const LAS char* qrope, int r32, int hi, float cinit) {
#pragma unroll
    for (int r = 0; r < 16; ++r) { p0[r] = cinit; p1[r] = cinit; }
    const int sw = kswz<DQK>(r32);
    const LAS char* k0 = Ks + r32 * (DQK * 2); const LAS char* k1 = Ks + (32 + r32) * (DQK * 2);
#pragma unroll
    for (int d0 = 0; d0 < DQK / 16; ++d0) { const int off = ((2 * d0 + hi) ^ sw) << 4;
        const bf16x8 b0 = *(const LAS bf16x8*)(k0 + off), b1 = *(const LAS bf16x8*)(k1 + off);
        bf16x8 qv; if (d0 < 8) qv = qr[d0 < 8 ? d0 : 0]; else qv = *(const LAS bf16x8*)(qrope + r32 * 128 + (((2 * (d0 - 8) + hi) ^ ((r32 >> 1) & 7)) << 4));
        p0 = __builtin_amdgcn_mfma_f32_32x32x16_bf16(b0, qv, p0, 0, 0, 0);
        p1 = __builtin_amdgcn_mfma_f32_32x32x16_bf16(b1, qv, p1, 0, 0, 0);
        if ((d0 & 3) == 3) SBAR(); }
}
__device__ __forceinline__ int v_st(int k, int c) { const int kk = (k & ~0xC) | ((k & 4) << 1) | ((k & 8) >> 1); return ((kk >> 3) * 4 + (c >> 5)) * 512 + ((kk & 7) * 32 + (c & 31)) * 2; }
__device__ __forceinline__ int v_rd_base(int lane) { return ((lane & 3) << 3) | (((lane >> 2) & 3) << 6) | (((lane >> 4) & 1) << 5) | (((lane >> 5) & 1) << 8); }
constexpr int v_rd_off(int d0, int ks, int half) { return d0 * 512 + ks * 4096 + half * 2048; }
template <int OFF> __device__ __forceinline__ s16x4 tr_read(int vb) { s16x4 r; asm volatile("ds_read_b64_tr_b16 %0, %1 offset:%2" : "=&v"(r) : "v"(vb), "i"(OFF) : "memory"); return r; }
template <int D0> __device__ __forceinline__ void pv_one(f32x16& od, int vb, bf16x8 pa0, bf16x8 pa1, bf16x8 pa2, bf16x8 pa3) {
    const s16x4 l0 = tr_read<v_rd_off(D0, 0, 0)>(vb), h0 = tr_read<v_rd_off(D0, 0, 1)>(vb), l1 = tr_read<v_rd_off(D0, 1, 0)>(vb), h1 = tr_read<v_rd_off(D0, 1, 1)>(vb);
    const s16x4 l2 = tr_read<v_rd_off(D0, 2, 0)>(vb), h2 = tr_read<v_rd_off(D0, 2, 1)>(vb), l3 = tr_read<v_rd_off(D0, 3, 0)>(vb), h3 = tr_read<v_rd_off(D0, 3, 1)>(vb);
    asm volatile("s_waitcnt lgkmcnt(0)" ::: "memory"); SBAR();
#define PK(L, H) (bf16x8){L[0], L[1], L[2], L[3], H[0], H[1], H[2], H[3]}
    od = __builtin_amdgcn_mfma_f32_32x32x16_bf16(pa0, PK(l0, h0), od, 0, 0, 0);
    od = __builtin_amdgcn_mfma_f32_32x32x16_bf16(pa1, PK(l1, h1), od, 0, 0, 0);
    od = __builtin_amdgcn_mfma_f32_32x32x16_bf16(pa2, PK(l2, h2), od, 0, 0, 0);
    od = __builtin_amdgcn_mfma_f32_32x32x16_bf16(pa3, PK(l3, h3), od, 0, 0, 0);
#undef PK
}
__device__ __forceinline__ void pv_d0(f32x16* o, int vb, bf16x8 pa0, bf16x8 pa1, bf16x8 pa2, bf16x8 pa3) {
    pv_one<0>(o[0], vb, pa0, pa1, pa2, pa3); pv_one<1>(o[1], vb, pa0, pa1, pa2, pa3); pv_one<2>(o[2], vb, pa0, pa1, pa2, pa3); pv_one<3>(o[3], vb, pa0, pa1, pa2, pa3);
}
template <bool DIFF> __device__ __forceinline__ void mask_tile(f32x16& p0, f32x16& p1, int t, int qpos, int hi, const LAS float* bt) {
    const float NEG = -INFINITY; const int kb = 64 * t + 4 * hi;
#pragma unroll
    for (int r = 0; r < 16; ++r) { const int kv = kb + (r & 3) + 8 * (r >> 2);
        if (DIFF) { const int d0 = qpos - kv, d1 = d0 - 32;
            const float b0 = bt[d0 < 0 ? 0 : (d0 > 255 ? 255 : d0)], b1 = bt[d1 < 0 ? 0 : (d1 > 255 ? 255 : d1)];
            p0[r] = d0 < 0 ? NEG : p0[r] + b0; p1[r] = d1 < 0 ? NEG : p1[r] + b1;
        } else { if (kv > qpos) p0[r] = NEG; if (kv + 32 > qpos) p1[r] = NEG; } }
}

template <int DQK, bool DIFF>
__device__ __forceinline__ void attn_unit(const bf16_t* __restrict__ Qb, const bf16_t* __restrict__ Kh, const bf16_t* __restrict__ Vh, int b, int qpos0, int nrows, int NT,
                                          const float* btg, float cinit, bf16_t* Ob, float* Of, int ldo, LAS char* lds) {
    constexpr int SHM_K = KVBLK * DQK * 2, NKC = DQK / 8, KPT = NKC / 8;
    int tid_ = threadIdx.x; asm volatile("" : "+v"(tid_));
    const int tid = tid_, wid = tid >> 6, lane = tid & 63, r32 = lane & 31, hi = lane >> 5;
    LAS char* V_lds = lds + OFF_V; LAS char* K_lds = lds + OFF_K;
    LAS float* ws = (LAS float*)(lds + OFF_WS) + wid * 64; LAS float* li_l = ws; LAS float* al_l = ws + 32;
    LAS float* bt = (LAS float*)(lds + OFF_BT);
    if (DIFF) { if (tid < 256) bt[tid] = btg[tid]; }
    float m_reg = -1e30f, l_reg = 0; f32x16 o[4];
#pragma unroll
    for (int d = 0; d < 4; ++d)
#pragma unroll
        for (int r = 0; r < 16; ++r) o[d][r] = 0.f;
    bf16x8 qr[8];
    const bf16_t* Qw = Qb + (size_t)(wid * QBLK + r32) * DQK + hi * 8;
    const LAS char* qrope = lds + OFF_QR + wid * 4096;
#pragma unroll
    for (int d0 = 0; d0 < 8; ++d0) qr[d0] = *(const bf16x8*)(Qw + d0 * 16);
    if (DQK > 128) {
#pragma unroll
        for (int d0 = 8; d0 < DQK / 16; ++d0) *(LAS bf16x8*)(lds + OFF_QR + wid * 4096 + r32 * 128 + (((2 * (d0 - 8) + hi) ^ ((r32 >> 1) & 7)) << 4)) = *(const bf16x8*)(Qw + d0 * 16);
    }
    const int sr = tid >> 4, sc = (tid & 15) * 8, vst0 = v_st(sr, sc), vst1 = v_st(32 + sr, sc);
    const int vb0 = (int)(uintptr_t)V_lds + v_rd_base(lane);
    const int qposw = qpos0 + wid * QBLK, qpos = qposw + r32;
    int krow[KPT], kch[KPT], kdst[KPT];
#pragma unroll
    for (int i = 0; i < KPT; ++i) { const int idx = tid + 512 * i; krow[i] = idx / NKC; kch[i] = idx - krow[i] * NKC; kdst[i] = krow[i] * (DQK * 2) + ((kch[i] ^ kswz<DQK>(krow[i])) << 4); }
    bf16x8 vs0, vs1, ks[KPT];
#define SLOAD(k0) do { vs0 = *(const bf16x8*)(Vh + (size_t)((k0) + sr) * DV + sc); vs1 = *(const bf16x8*)(Vh + (size_t)((k0) + 32 + sr) * DV + sc); \
    _Pragma("unroll") for (int i_ = 0; i_ < KPT; ++i_) ks[i_] = *(const bf16x8*)(Kh + (size_t)((k0) + krow[i_]) * DQK + kch[i_] * 8); } while (0)
#define SWRITE(bb) do { *(LAS bf16x8*)(V_lds + (bb) * SHM_V + vst0) = vs0; *(LAS bf16x8*)(V_lds + (bb) * SHM_V + vst1) = vs1; \
    _Pragma("unroll") for (int i_ = 0; i_ < KPT; ++i_) *(LAS bf16x8*)(K_lds + (bb) * SHM_K + kdst[i_]) = ks[i_]; } while (0)
#define SWAIT() asm volatile("s_waitcnt vmcnt(0)" ::: "memory")
#define RESC(a) do { if (__any((a) < 1.f)) { if (hi == 0) al_l[r32] = (a); asm volatile("s_waitcnt lgkmcnt(0)" ::: "memory"); \
    _Pragma("unroll") for (int d = 0; d < 4; ++d) _Pragma("unroll") for (int r = 0; r < 16; ++r) o[d][r] *= al_l[crow(r, hi)]; } } while (0)
#define MASK(P0, P1, t) do { if (DIFF ? (qposw - (64 * (t) + 63) < 113) : (64 * (t) + 63 > qposw)) mask_tile<DIFF>(P0, P1, (t), qpos, hi, bt); } while (0)
    f32x16 p0, p1; float al; bf16x8 pa0, pa1, pa2, pa3;
    SLOAD(0); SWAIT(); SWRITE(0); __syncthreads();
    for (int j = 0; j < NT; ++j) {
        const int buf = j & 1;
        if (j + 1 < NT) SLOAD((j + 1) * KVBLK);
        SBAR(); qkt<DQK>(p0, p1, K_lds + buf * SHM_K, qr, qrope, r32, hi, cinit); MASK(p0, p1, j);
        partialSM(p0, p1, m_reg, al); RESC(al);
        finishSM(p0, p1, al, l_reg, pa0, pa1, pa2, pa3); SBAR();
        pv_d0(o, vb0 + buf * SHM_V, pa0, pa1, pa2, pa3);
        if (j + 1 < NT) { SWAIT(); SWRITE(buf ^ 1); }
        __syncthreads();
    }
    if (hi == 0) li_l[r32] = l_reg; asm volatile("s_waitcnt lgkmcnt(0)" ::: "memory");
#pragma unroll
    for (int r = 0; r < 16; ++r) { const int lr = wid * QBLK + crow(r, hi), pos = qpos0 + lr; const float rl = __builtin_amdgcn_rcpf(li_l[crow(r, hi)]);
        const int mrow = pos >= NMETA ? b * SEQ + pos - NMETA : MMAIN + pos;
        if (lr < nrows && (pos >= NMETA || b == 0)) {
#pragma unroll
            for (int d0 = 0; d0 < 4; ++d0) { if (DIFF) Of[(size_t)mrow * ldo + d0 * 32 + r32] = o[d0][r] * rl; else Ob[(size_t)mrow * ldo + d0 * 32 + r32] = (bf16_t)f2bf(o[d0][r] * rl); } } }
    __syncthreads();
#undef SLOAD
#undef SWRITE
#undef SWAIT
#undef RESC
#undef MASK
}
#undef SBAR
}

#define XB_TMO      128
#define XB_XCNT(j)  (256  + 64 * (j))
#define XB_XSUB(j)  (1280 + 64 * (j))
#define XB_XGEN(j)  (2304 + 64 * (j))
#define XB_TOP      3328
#define XB_TOPGEN   3392
#define XCD_BAR_WORDS 3456
#define XB_SPIN_CAP (1u << 18)
__device__ __forceinline__ unsigned xb_ld(unsigned* p)              { return __hip_atomic_load(p, __ATOMIC_RELAXED, __HIP_MEMORY_SCOPE_AGENT); }
__device__ __forceinline__ unsigned xb_add(unsigned* p, unsigned v) { return __hip_atomic_fetch_add(p, v, __ATOMIC_RELAXED, __HIP_MEMORY_SCOPE_AGENT); }
__device__ __forceinline__ unsigned xb_xcc_id() { return (unsigned)__builtin_amdgcn_s_getreg((3 << 11) | 20) & 0xFu; }
#define XB_SPIN(cond, bar) do { unsigned _sp = 0; while (cond) { __builtin_amdgcn_s_sleep(1); \
    if ((++_sp & 255u) == 0u) { if (xb_ld(&(bar)[XB_TMO])) break; if (_sp > XB_SPIN_CAP) { atomicAdd(&(bar)[XB_TMO], 1u); break; } } } } while (0)
struct XcdBarrier { unsigned* bar; unsigned x; volatile LAS unsigned* st; };
__device__ __forceinline__ XcdBarrier xcd_barrier_post(unsigned* bar, volatile LAS unsigned* st) {
    XcdBarrier b; b.bar = bar; b.x = xb_xcc_id(); b.st = st;
    if (threadIdx.x == 0) (void)xb_add(&bar[XB_XCNT(b.x)], 1u);
    return b;
}
__device__ __forceinline__ void xcd_barrier_complete(unsigned* bar, unsigned x, unsigned& nloc, unsigned& nx) {
    const unsigned G = gridDim.x * gridDim.y * gridDim.z;
    unsigned sum, cnt, mine, sp = 0u;
    for (;;) {
        sum = 0u; cnt = 0u; mine = 0u;
#pragma unroll
        for (unsigned j = 0; j < 16; ++j) { const unsigned c = xb_ld(&bar[XB_XCNT(j)]); sum += c; cnt += (c > 0u) ? 1u : 0u; mine = (j == x) ? c : mine; }
        if (sum == G) break;
        __builtin_amdgcn_s_sleep(1);
        if ((++sp & 255u) == 0u) { if (xb_ld(&bar[XB_TMO])) break; if (sp > XB_SPIN_CAP) { atomicAdd(&bar[XB_TMO], 1u); break; } }
    }
    nloc = mine > 0u ? mine : 1u; nx = cnt > 0u ? cnt : 1u;
}
__device__ __forceinline__ void xcd_barrier(const XcdBarrier& b) {
    asm volatile("s_waitcnt vmcnt(0)" ::: "memory");
    __syncthreads();
    if (threadIdx.x == 0) {
        unsigned* bar = b.bar;
        __builtin_amdgcn_s_waitcnt(0);
        unsigned nloc = b.st[0], nx = b.st[1];
        if (nloc == 0u) { xcd_barrier_complete(bar, b.x, nloc, nx); b.st[0] = nloc; b.st[1] = nx; }
        const unsigned old = xb_add(&bar[XB_XSUB(b.x)], 1u);
        const unsigned gen = old / nloc;
        if (old + 1u == (gen + 1u) * nloc) {
            __builtin_amdgcn_fence(__ATOMIC_RELEASE, "agent");
            asm volatile("s_waitcnt vmcnt(0)" ::: "memory");
            const unsigned og = xb_add(&bar[XB_TOP], 1u);
            const unsigned tg = og / nx;
            if (og + 1u == (tg + 1u) * nx) xb_add(&bar[XB_TOPGEN], 1u);
            else XB_SPIN(xb_ld(&bar[XB_TOPGEN]) == tg, bar);
            __builtin_amdgcn_fence(__ATOMIC_ACQUIRE, "agent");
            xb_add(&bar[XB_XGEN(b.x)], 1u);
            asm volatile("s_waitcnt vmcnt(0)" ::: "memory");
        } else {
            XB_SPIN(xb_ld(&bar[XB_XGEN(b.x)]) == gen, bar);
            __builtin_amdgcn_fence(__ATOMIC_ACQUIRE, "agent");
            asm volatile("s_waitcnt vmcnt(0)" ::: "memory");
        }
    }
    __syncthreads();
}

template <int MAP> __device__ __forceinline__ int wmap(int n) { return MAP == 1 ? map_win(n) : MAP == 2 ? map_wuq(n) : MAP == 3 ? map_wup(n) : n; }
template <int MAP> __device__ __forceinline__ void p0_transpose_item(const float* W, int K, int N, bf16_t* WT, LAS float* scr, int item, int lane) {
    const int nblk = N / 32, kb = item / nblk, nb = item % nblk, k0 = 64 * kb, n0 = 32 * nb;
#pragma unroll 8
    for (int i = 0; i < 32; ++i) { const int kk = 2 * i + (lane >> 5); scr[kk * 33 + (lane & 31)] = W[(size_t)(k0 + kk) * N + n0 + (lane & 31)]; }
    LDS_WAIT(); asm volatile("" ::: "memory");
    const int c = lane & 7;
#pragma unroll
    for (int j = 0; j < 4; ++j) { const int n = (lane >> 3) + 8 * j; const LAS float* s = scr + (8 * c) * 33 + n;
        u32x4 o; o.x = pk2(s[0 * 33], s[1 * 33]); o.y = pk2(s[2 * 33], s[3 * 33]); o.z = pk2(s[4 * 33], s[5 * 33]); o.w = pk2(s[6 * 33], s[7 * 33]);
        *(u32x4*)(WT + (size_t)wmap<MAP>(n0 + n) * K + k0 + 8 * c) = o; }
    LDS_WAIT(); asm volatile("" ::: "memory");
}
__device__ __forceinline__ float row_load(const float* row, int lane, f32x4 (&v)[8]) {
    float s = 0.f;
#pragma unroll
    for (int j = 0; j < 8; ++j) { v[j] = *(const f32x4*)(row + 4 * lane + 256 * j); s += (v[j][0] * v[j][0] + v[j][1] * v[j][1]) + (v[j][2] * v[j][2] + v[j][3] * v[j][3]); }
    return wave_sum(s);
}
__device__ __forceinline__ int t5_bucket(int n) {
    if (n < 16) return n;
    int lg = 16 + (int)(logf((float)n / 16.0f) / 2.0794415416798357f * 16.0f);
    return lg < 31 ? lg : 31;
}

struct Args { const float* in[22]; float* out; unsigned char* ws; int ph_lo, ph_hi; };

__global__ void __launch_bounds__(512, 2) hymba_fwd(Args args) {
    extern __shared__ __attribute__((aligned(16))) unsigned char lds_raw[];
    LAS unsigned char* lds = (LAS unsigned char*)lds_raw;
    volatile LAS unsigned* MISC = (volatile LAS unsigned*)(lds + MISC_OFF);
    const int tid = threadIdx.x, lane = tid & 63, wave = __builtin_amdgcn_readfirstlane(tid >> 6);
    const int G = gridDim.x; const int bx = blockIdx.x; const int vcu = (G % 8 == 0) ? (bx % 8) * (G / 8) + bx / 8 : bx;
    const int gw = vcu * 8 + wave, NGW = G * 8;
    unsigned char* ws = args.ws;
    unsigned* ctl = (unsigned*)(ws + WS_CTL);
    const float* x = args.in[0]; const float* meta = args.in[1]; const float* rel_bias = args.in[2];
    const float* w_in = args.in[3]; const float* w_uq = args.in[4]; const float* w_ukv = args.in[5]; const float* w_o = args.in[6];
    const float* g_attn_pre = args.in[7]; const float* g_attn_post = args.in[8]; const float* g_cq = args.in[9]; const float* g_ckv = args.in[10];
    const float* lq1 = args.in[11]; const float* lk1 = args.in[12]; const float* lq2 = args.in[13]; const float* lk2 = args.in[14];
    const float* g_sub = args.in[15]; const float* g_ffn_pre = args.in[16]; const float* g_ffn_post = args.in[17];
    const float* w_up = args.in[18]; const float* conv_w = args.in[19]; const float* conv_b = args.in[20]; const float* w_down = args.in[21];
    float* CS = (float*)(ws + WS_CS); float* BT = (float*)(ws + WS_BT);
    bf16_t* W1t = (bf16_t*)(ws + WS_W1); bf16_t* Wuqt = (bf16_t*)(ws + WS_WUQ); bf16_t* Wukvt = (bf16_t*)(ws + WS_WUKV); bf16_t* Wot = (bf16_t*)(ws + WS_WO);
    bf16_t* Wupt = (bf16_t*)(ws + WS_WUP); bf16_t* Wdnt = (bf16_t*)(ws + WS_WDN);
    bf16_t* NR = (bf16_t*)(ws + WS_NR); bf16_t* LAT = (bf16_t*)(ws + WS_LAT); bf16_t* CQN = (bf16_t*)(ws + WS_CQN); bf16_t* CKVN = (bf16_t*)(ws + WS_CKVN);
    bf16_t* QD = (bf16_t*)(ws + WS_QD); bf16_t* KD = (bf16_t*)(ws + WS_KD); bf16_t* VD = (bf16_t*)(ws + WS_VD);
    bf16_t* QM = (bf16_t*)(ws + WS_QM); bf16_t* KM = (bf16_t*)(ws + WS_KM); bf16_t* VM = (bf16_t*)(ws + WS_VM);
    bf16_t* CAT = (bf16_t*)(ws + WS_CAT); float* DP = (float*)(ws + WS_DP); float* AO = (float*)(ws + WS_AO); float* HB = (float*)(ws + WS_H);
    bf16_t* N2 = (bf16_t*)(ws + WS_N2); bf16_t* ACT = (bf16_t*)(ws + WS_ACT); float* FB = (float*)(ws + WS_F);

    for (int u = tid; u < (LDS_BYTES - LDSCTL_OFF) / 4; u += 512) ((LAS unsigned*)(lds + LDSCTL_OFF))[u] = 0u;
    __syncthreads();
#if MK_ONE_LAUNCH
    XcdBarrier bar = xcd_barrier_post(ctl + CW_BAR, MISC + 8);
#define GRID_BAR() xcd_barrier(bar)
#else
#define GRID_BAR() do {} while (0)
#endif
    const int lo = args.ph_lo, hi = args.ph_hi;
#ifndef PHASE_MASK
#define PHASE_MASK 0x7ff
#endif
#define IN(k) ((((PHASE_MASK) >> (k)) & 1) && lo <= (k) && (k) < hi)
#define SEAM(k) do { if (IN(k) && IN((k) + 1)) GRID_BAR(); } while (0)

    if (IN(0)) {
        LAS float* scr = (LAS float*)(lds + wave * 16384);
        constexpr int I_IN = (DM / 64) * (DIN / 32), I_UQ = (QL / 64) * (NQM / 32), I_UKV = (KVL / 64) * (NKV / 32), I_O = (DM / 64) * (DM / 32), I_UP = (DM / 64) * (NUP / 32), I_DN = (DFF / 64) * (DM / 32);
        constexpr int NITEMS = I_IN + I_UQ + I_UKV + I_O + I_UP + I_DN;
        for (int it = gw; it < NITEMS; it += NGW) {
            int r = it;
            if (r < I_IN) { p0_transpose_item<1>(w_in, DM, DIN, W1t, scr, r, lane); continue; } r -= I_IN;
            if (r < I_UQ) { p0_transpose_item<2>(w_uq, QL, NQM, Wuqt, scr, r, lane); continue; } r -= I_UQ;
            if (r < I_UKV) { p0_transpose_item<0>(w_ukv, KVL, NKV, Wukvt, scr, r, lane); continue; } r -= I_UKV;
            if (r < I_O) { p0_transpose_item<0>(w_o, DM, DM, Wot, scr, r, lane); continue; } r -= I_O;
            if (r < I_UP) { p0_transpose_item<3>(w_up, DM, NUP, Wupt, scr, r, lane); continue; } r -= I_UP;
            p0_transpose_item<0>(w_down, DFF, DM, Wdnt, scr, r, lane);
        }
        for (int m = gw; m < MR; m += NGW) {
            u32x2* o8 = (u32x2*)(NR + (size_t)m * DM) + lane;
            if (m >= MMAIN + NMETA) {
#pragma unroll
                for (int j = 0; j < 8; ++j) o8[64 * j] = (u32x2){0u, 0u};
                continue; }
            const float* row = m < MMAIN ? x + (size_t)m * DM : meta + (size_t)(m - MMAIN) * DM;
            f32x4 v[8]; const float ss = row_load(row, lane, v); const float rstd = rsqrtf(ss * (1.f / DM) + EPS);
#pragma unroll
            for (int j = 0; j < 8; ++j) { const f32x4 gg = *(const f32x4*)(g_attn_pre + 4 * lane + 256 * j);
                o8[64 * j] = (u32x2){pk2(v[j][0] * rstd * gg[0], v[j][1] * rstd * gg[1]), pk2(v[j][2] * rstd * gg[2], v[j][3] * rstd * gg[3])}; }
        }
        for (int it = gw; it < 4 * 16 * 48; it += NGW) { const int which = it / (16 * 48), r = it % (16 * 48), slot = r / 48, pos = LREAL + r % 48;
            bf16_t* base = which == 0 ? KD : which == 1 ? VD : which == 2 ? KM : VM; const int rb = (which == 2) ? 384 : 256;
            if (lane * 16 < rb) *(u32x4*)((char*)base + ((size_t)slot * LPB + pos) * rb + lane * 16) = (u32x4){0u, 0u, 0u, 0u}; }
        for (int e = bx * 512 + tid; e < LREAL * 32; e += G * 512) { const int pos = e >> 5, i = e & 31;
            const double inv = pow(10000.0, -(double)i / 32.0), ang = (double)pos * inv; CS[2 * e] = (float)cos(ang); CS[2 * e + 1] = (float)sin(ang); }
        for (int e = bx * 512 + tid; e < 8 * 256 + 8; e += G * 512) {
            if (e < 2048) { const int mp = e >> 8, d = e & 255; BT[e] = (rel_bias[t5_bucket(d) * 8 + mp] - rel_bias[31 * 8 + mp]) * LOG2E; }
            else BT[e] = rel_bias[31 * 8 + (e - 2048)] * LOG2E; }
    }
    SEAM(0);
    if (IN(1)) {
        pg8::Gemm g{NR, W1t, DM, DM}; pg8::StaticOrder<0> S; S.init(MR / 256, NP1 / 256, G, bx);
        pg8::EpiG1 E{LAT, QD, KD, VD, DIFF_QSCALE};
        pg8::gemm_phase<pg8::EpiG1, pg8::StaticOrder<0>, true>(lds, g, S, E);
    }
    SEAM(1);
    if (IN(2)) {
        for (int m = gw; m < MMAIN + NMETA; m += NGW) {
            const bf16_t* row = LAT + (size_t)m * DLAT;
            { const u32x4 w = *(const u32x4*)(row + 8 * lane); float v[8]; float s = 0.f;
#pragma unroll
              for (int k = 0; k < 4; ++k) { v[2 * k] = bf2f(w[k]); v[2 * k + 1] = bf2f(w[k] >> 16); s += v[2 * k] * v[2 * k] + v[2 * k + 1] * v[2 * k + 1]; }
              const float rstd = rsqrtf(wave_sum(s) * (1.f / QL) + EPS); const f32x4 g0 = *(const f32x4*)(g_cq + 8 * lane), g1 = *(const f32x4*)(g_cq + 8 * lane + 4);
              u32x4 o; o.x = pk2(v[0] * rstd * g0[0], v[1] * rstd * g0[1]); o.y = pk2(v[2] * rstd * g0[2], v[3] * rstd * g0[3]); o.z = pk2(v[4] * rstd * g1[0], v[5] * rstd * g1[1]); o.w = pk2(v[6] * rstd * g1[2], v[7] * rstd * g1[3]);
              *(u32x4*)(CQN + (size_t)m * QL + 8 * lane) = o; }
            { const int l4 = lane & 31; const u32x4 w = *(const u32x4*)(row + QL + 8 * l4); float v[8]; float s = 0.f;
#pragma unroll
              for (int k = 0; k < 4; ++k) { v[2 * k] = bf2f(w[k]); v[2 * k + 1] = bf2f(w[k] >> 16); s += v[2 * k] * v[2 * k] + v[2 * k + 1] * v[2 * k + 1]; }
              if (lane >= 32) s = 0.f;
              const float rstd = rsqrtf(wave_sum(s) * (1.f / KVL) + EPS); const f32x4 g0 = *(const f32x4*)(g_ckv + 8 * l4), g1 = *(const f32x4*)(g_ckv + 8 * l4 + 4);
              u32x4 o; o.x = pk2(v[0] * rstd * g0[0], v[1] * rstd * g0[1]); o.y = pk2(v[2] * rstd * g0[2], v[3] * rstd * g0[3]); o.z = pk2(v[4] * rstd * g1[0], v[5] * rstd * g1[1]); o.w = pk2(v[6] * rstd * g1[2], v[7] * rstd * g1[3]);
              if (lane < 32) *(u32x4*)(CKVN + (size_t)m * KVL + 8 * l4) = o; }
            { const int i = lane & 31; const unsigned w = *(const unsigned*)(row + 768 + 2 * i); const float x1 = bf2f(w), x2 = bf2f(w >> 16);
              int b0, pos, nb; if (m < MMAIN) { b0 = m >> 12; pos = NMETA + (m & 4095); nb = 1; } else { b0 = 0; pos = m - MMAIN; nb = 2; }
              const f32x2 csv = *(const f32x2*)(CS + ((size_t)pos * 32 + i) * 2);
              const unsigned o = pk2(x1 * csv[0] - x2 * csv[1], x2 * csv[0] + x1 * csv[1]);
              for (int k = 0; k < nb; ++k)
#pragma unroll
                  for (int hh = 0; hh < 4; ++hh) { const int h = hh + 4 * (lane >> 5); *(unsigned*)(KM + ((size_t)((b0 + k) * 8 + h) * LPB + pos) * 192 + 128 + 2 * i) = o; } }
        }
    }
    SEAM(2);
    if (IN(3)) {
#ifndef G2_SEL
#define G2_SEL 3
#endif
        if (G2_SEL & 1) { pg8::Gemm g{CQN, Wuqt, QL, QL}; pg8::StaticOrder<0> S; S.init(MR / 256, NQM / 256, G, bx);
          pg8::EpiQm E{QM, CS, MLA_QSCALE};
          pg8::gemm_phase<pg8::EpiQm, pg8::StaticOrder<0>, true>(lds, g, S, E); }
        if (G2_SEL & 2) { pg8::Gemm g{CKVN, Wukvt, KVL, KVL}; pg8::StaticOrder<0> S; S.init(MR / 256, NKV / 256, G, bx);
          pg8::EpiKv E{KM, VM};
          pg8::gemm_phase<pg8::EpiKv, pg8::StaticOrder<0>, true>(lds, g, S, E); }
    }
    SEAM(3);
    if (IN(4)) {
        LAS char* al = (LAS char*)lds; volatile LAS int* uslot = (volatile LAS int*)(al + att::OFF_U);
        for (;;) {
            if (tid == 0) uslot[0] = (int)__hip_atomic_fetch_add(ctl + CW_QUEUE, 1u, RLX_AGENT);
            __syncthreads();
            const int u = __builtin_amdgcn_readfirstlane(uslot[0]);
            __syncthreads();
            if (u >= 17 * 48) break;
            const int qb = 16 - u / 48, rem = u % 48, b = rem / 24, vh = rem % 24;
            const int qpos0 = qb == 0 ? 0 : NMETA + 256 * (qb - 1), nrows = qb == 0 ? NMETA : 256, NT = qb == 0 ? 1 : 4 * qb + 1;
#ifndef ATT_SEL
#define ATT_SEL 3
#endif
            if (vh < 8) { if (ATT_SEL & 1) { const size_t hb = (size_t)(b * 8 + vh) * LPB;
                att::attn_unit<192, false>(QM + (hb + qpos0) * 192, KM + hb * 192, VM + hb * 128, b, qpos0, nrows, NT, nullptr, 0.f, CAT + vh * 128, nullptr, DM, al); }
            } else if (ATT_SEL & 2) { const int d = vh - 8, hc = d >> 1, vhalf = d & 1, h = d >> 2; const size_t hb = (size_t)(b * 8 + hc) * LPB;
                att::attn_unit<128, true>(QD + (hb + qpos0) * 128, KD + hb * 128, VD + (size_t)(b * 8 + h * 2 + vhalf) * LPB * 128, b, qpos0, nrows, NT, BT + hc * 256, BT[2048 + hc], nullptr, DP + hc * 256 + vhalf * 128, DM, al); }
        }
    }
    SEAM(4);
    if (IN(5)) {
        float lam;
        { const float a = wave_sum(lq1[lane] * lk1[lane] + lq1[lane + 64] * lk1[lane + 64]), c = wave_sum(lq2[lane] * lk2[lane] + lq2[lane + 64] * lk2[lane + 64]); lam = expf(a) - expf(c) + LAM_INIT; }
        const f32x4 gs = *(const f32x4*)(g_sub + 4 * lane);
        for (int it = gw; it < (MMAIN + NMETA) * 4; it += NGW) { const int m = it >> 2, h = it & 3;
            const f32x4 a0 = *(const f32x4*)(DP + (size_t)m * DM + (h * 2 + 0) * 256 + 4 * lane), a1 = *(const f32x4*)(DP + (size_t)m * DM + (h * 2 + 1) * 256 + 4 * lane);
            const f32x4 dd = a0 - lam * a1; const float rstd = rsqrtf(wave_sum((dd[0] * dd[0] + dd[1] * dd[1]) + (dd[2] * dd[2] + dd[3] * dd[3])) * (1.f / 256.f) + EPS) * (1.f - LAM_INIT);
            *(u32x2*)(CAT + (size_t)m * DM + 1024 + 256 * h + 4 * lane) = (u32x2){pk2(dd[0] * rstd * gs[0], dd[1] * rstd * gs[1]), pk2(dd[2] * rstd * gs[2], dd[3] * rstd * gs[3])}; }
    }
    SEAM(5);
    if (IN(6)) {
        pg8::Gemm g{CAT, Wot, DM, DM}; pg8::StaticOrder<0> S; S.init(MR / 256, DM / 256, G, bx);
        pg8::EpiF32 E{AO, DM};
        pg8::gemm_phase<pg8::EpiF32, pg8::StaticOrder<0>, true>(lds, g, S, E);
    }
    SEAM(6);
    if (IN(7)) {
        for (int m = gw; m < MMAIN + NMETA; m += NGW) {
            f32x4 a[8]; const float sa = row_load(AO + (size_t)m * DM, lane, a); const float rs1 = rsqrtf(sa * (1.f / DM) + EPS);
            const float* row0 = m < MMAIN ? x + (size_t)m * DM : meta + (size_t)(m - MMAIN) * DM; float s2 = 0.f;
#pragma unroll
            for (int j = 0; j < 8; ++j) { const f32x4 gg = *(const f32x4*)(g_attn_post + 4 * lane + 256 * j), h0 = *(const f32x4*)(row0 + 4 * lane + 256 * j);
                a[j] = h0 + a[j] * rs1 * gg; s2 += (a[j][0] * a[j][0] + a[j][1] * a[j][1]) + (a[j][2] * a[j][2] + a[j][3] * a[j][3]);
                *(f32x4*)(HB + (size_t)m * DM + 4 * lane + 256 * j) = a[j]; }
            const float rs2 = rsqrtf(wave_sum(s2) * (1.f / DM) + EPS);
            int b0, pos, nb; if (m < MMAIN) { b0 = m >> 12; pos = NMETA + (m & 4095); nb = 1; } else { b0 = 0; pos = m - MMAIN; nb = 2; }
#pragma unroll
            for (int j = 0; j < 8; ++j) { const f32x4 gg = *(const f32x4*)(g_ffn_pre + 4 * lane + 256 * j);
                const u32x2 o = (u32x2){pk2(a[j][0] * rs2 * gg[0], a[j][1] * rs2 * gg[1]), pk2(a[j][2] * rs2 * gg[2], a[j][3] * rs2 * gg[3])};
                for (int k = 0; k < nb; ++k) *(u32x2*)(N2 + ((size_t)(b0 + k) * LPB + pos) * DM + 4 * lane + 256 * j) = o; }
        }
    }
    SEAM(7);
    if (IN(8)) {
        pg8::Gemm g{N2, Wupt, DM, DM}; pg8::StaticOrder<1> S; S.init(34, NUP / 256, G, bx);
        pg8::EpiConv E{ACT, conv_w, conv_b, (LAS float*)(lds + XCONV_OFF)};
        pg8::gemm_phase<pg8::EpiConv, pg8::StaticOrder<1>, true>(lds, g, S, E);
    }
    SEAM(8);
    if (IN(9)) {
        pg8::Gemm g{ACT, Wdnt, DFF, DFF}; pg8::StaticOrder<0> S; S.init(MMAIN / 256, DM / 256, G, bx);
        pg8::EpiF32 E{FB, DM};
        pg8::gemm_phase<pg8::EpiF32, pg8::StaticOrder<0>, true>(lds, g, S, E);
    }
    SEAM(9);
    if (IN(10)) {
        for (int m = gw; m < MMAIN; m += NGW) {
            f32x4 a[8]; const float sa = row_load(FB + (size_t)m * DM, lane, a); const float rs = rsqrtf(sa * (1.f / DM) + EPS);
#pragma unroll
            for (int j = 0; j < 8; ++j) { const f32x4 gg = *(const f32x4*)(g_ffn_post + 4 * lane + 256 * j), hh = *(const f32x4*)(HB + (size_t)m * DM + 4 * lane + 256 * j);
                *(f32x4*)(args.out + (size_t)m * DM + 4 * lane + 256 * j) = hh + a[j] * rs * gg; }
        }
    }
#undef IN
#undef SEAM
}

#if DEBUG_CHECK
__device__ __forceinline__ unsigned hash_u(unsigned a) { a ^= a >> 16; a *= 0x7feb352du; a ^= a >> 15; a *= 0x846ca68bu; a ^= a >> 16; return a; }
__device__ __forceinline__ float bfr(float v) { return bf2f(f2bf(v)); }
__device__ __forceinline__ void chk_rec(unsigned* chk, int stage, float got, float want, float rtol, float atol) {
    float ratio = fabsf(got - want) / (atol + rtol * fabsf(want)); if (!(ratio == ratio)) ratio = 1e30f;
    atomicMax(chk + stage, __float_as_uint(ratio));
}
struct CArgs { const float* in[22]; float* out; unsigned char* ws; };
__global__ void __launch_bounds__(64) chk_kernel(CArgs a, int stage, int nsamp) {
    const int lane = threadIdx.x; unsigned char* ws = a.ws; unsigned* chk = (unsigned*)(ws + WS_CHK);
    const float* x = a.in[0]; const float* meta = a.in[1]; const float* rel_bias = a.in[2]; const float* w_in = a.in[3]; const float* w_uq = a.in[4]; const float* w_ukv = a.in[5]; const float* w_o = a.in[6];
    const float* g_attn_pre = a.in[7]; const float* g_attn_post = a.in[8]; const float* g_cq = a.in[9]; const float* g_ckv = a.in[10];
    const float* g_sub = a.in[15]; const float* g_ffn_pre = a.in[16]; const float* w_up = a.in[18]; const float* conv_w = a.in[19]; const float* conv_b = a.in[20]; const float* w_down = a.in[21];
    const float* CS = (const float*)(ws + WS_CS);
    const bf16_t* NR = (const bf16_t*)(ws + WS_NR); const bf16_t* LAT = (const bf16_t*)(ws + WS_LAT); const bf16_t* CQN = (const bf16_t*)(ws + WS_CQN); const bf16_t* CKVN = (const bf16_t*)(ws + WS_CKVN);
    const bf16_t* QD = (const bf16_t*)(ws + WS_QD); const bf16_t* KD = (const bf16_t*)(ws + WS_KD); const bf16_t* VD = (const bf16_t*)(ws + WS_VD);
    const bf16_t* QM = (const bf16_t*)(ws + WS_QM); const bf16_t* KM = (const bf16_t*)(ws + WS_KM); const bf16_t* VM = (const bf16_t*)(ws + WS_VM);
    const bf16_t* CAT = (const bf16_t*)(ws + WS_CAT); const float* DP = (const float*)(ws + WS_DP); const float* AO = (const float*)(ws + WS_AO); const float* HB = (const float*)(ws + WS_H);
    const bf16_t* N2 = (const bf16_t*)(ws + WS_N2); const bf16_t* ACT = (const bf16_t*)(ws + WS_ACT); const float* FB = (const float*)(ws + WS_F);
    __shared__ float pbuf[LREAL + 64];
    const int s = blockIdx.x; const unsigned h0 = hash_u(s * 2654435761u + stage * 97u), h1 = hash_u(h0 + 12345u), h2 = hash_u(h1 + 777u);
    int m = (s % 8 == 0) ? MMAIN + (h0 % NMETA) : (int)(h0 % MMAIN);
    if (s % 8 == 1) m = (h0 & 1) * SEQ + (h1 % 4);
    if (s % 8 == 2) m = (h0 & 1) * SEQ + SEQ - 1 - (h1 % 4);
    int b, pos; if (m < MMAIN) { b = m >> 12; pos = NMETA + (m & 4095); } else { b = h2 & 1; pos = m - MMAIN; }
    const float* row0 = m < MMAIN ? x + (size_t)m * DM : meta + (size_t)(m - MMAIN) * DM;
    if (stage == 1) {
        float ss = 0.f; for (int k = lane; k < DM; k += 64) ss += row0[k] * row0[k]; ss = wave_sum(ss); const float rstd = rsqrtf(ss / DM + EPS);
        const int c = h1 % DM; if (lane == 0) chk_rec(chk, 1, bf2f(NR[(size_t)m * DM + c]), row0[c] * rstd * g_attn_pre[c], 1e-2f, 1e-3f);
        if (lane == 1) { const int mz = MMAIN + NMETA + (h1 % (MR - MMAIN - NMETA)); chk_rec(chk, 1, bf2f(NR[(size_t)mz * DM + c]), 0.f, 1e-2f, 1e-6f); }
    } else if (stage == 2) {
        const int n = h1 % DIN; float d = 0.f; for (int k = lane; k < DM; k += 64) d += bf2f(NR[(size_t)m * DM + k]) * bfr(w_in[(size_t)k * DIN + n]); d = wave_sum(d);
        float got;
        if (n < 832) { got = bf2f(LAT[(size_t)m * DLAT + map_win(n)]); }
        else { const int r = n - 832, typ = r >> 10, hc = (r & 1023) >> 7, col = r & 127; const bf16_t* base = typ == 0 ? QD : typ == 1 ? KD : VD; if (typ == 0) d *= DIFF_QSCALE;
            got = bf2f(base[((size_t)(b * 8 + hc) * LPB + pos) * 128 + col]); }
        if (lane == 0) chk_rec(chk, 2, got, d, 2e-2f, 2e-2f);
    } else if (stage == 3) {
        float ss = 0.f; for (int k = lane; k < QL; k += 64) { const float v = bf2f(LAT[(size_t)m * DLAT + k]); ss += v * v; } ss = wave_sum(ss);
        float s2 = 0.f; for (int k = lane; k < KVL; k += 64) { const float v = bf2f(LAT[(size_t)m * DLAT + QL + k]); s2 += v * v; } s2 = wave_sum(s2);
        const int c = h1 % QL, c2 = h1 % KVL, i = h2 % 32, hh = (h2 >> 8) % 8;
        if (lane == 0) chk_rec(chk, 3, bf2f(CQN[(size_t)m * QL + c]), bf2f(LAT[(size_t)m * DLAT + c]) * rsqrtf(ss / QL + EPS) * g_cq[c], 1e-2f, 1e-3f);
        if (lane == 1) chk_rec(chk, 3, bf2f(CKVN[(size_t)m * KVL + c2]), bf2f(LAT[(size_t)m * DLAT + QL + c2]) * rsqrtf(s2 / KVL + EPS) * g_ckv[c2], 1e-2f, 1e-3f);
        if (lane == 2) { const float x1 = bf2f(LAT[(size_t)m * DLAT + 768 + 2 * i]), x2 = bf2f(LAT[(size_t)m * DLAT + 768 + 2 * i + 1]);
            const double inv = pow(10000.0, -(double)i / 32.0), ang = pos * inv; const float cc = (float)cos(ang), sn = (float)sin(ang);
            const bf16_t* kr = KM + ((size_t)(b * 8 + hh) * LPB + pos) * 192 + 128 + 2 * i;
            chk_rec(chk, 3, bf2f(kr[0]), x1 * cc - x2 * sn, 1e-2f, 2e-3f); chk_rec(chk, 3, bf2f(kr[1]), x2 * cc + x1 * sn, 1e-2f, 2e-3f); }
    } else if (stage == 4) {
        const int h = h1 % 8;
        { const int d = h2 % 128; float q = 0.f; for (int k = lane; k < QL; k += 64) q += bf2f(CQN[(size_t)m * QL + k]) * bfr(w_uq[(size_t)k * NQM + h * 192 + d]); q = wave_sum(q);
          if (lane == 0) chk_rec(chk, 4, bf2f(QM[((size_t)(b * 8 + h) * LPB + pos) * 192 + d]), q * MLA_QSCALE, 2e-2f, 1e-2f); }
        { const int i = (h2 >> 8) % 32; float q1 = 0.f, q2 = 0.f; for (int k = lane; k < QL; k += 64) { const float c = bf2f(CQN[(size_t)m * QL + k]); q1 += c * bfr(w_uq[(size_t)k * NQM + h * 192 + 128 + i]); q2 += c * bfr(w_uq[(size_t)k * NQM + h * 192 + 160 + i]); }
          q1 = wave_sum(q1); q2 = wave_sum(q2); const double inv = pow(10000.0, -(double)i / 32.0), ang = pos * inv; const float cc = (float)cos(ang), sn = (float)sin(ang);
          const bf16_t* qp = QM + ((size_t)(b * 8 + h) * LPB + pos) * 192 + 128 + 2 * i;
          if (lane == 0) { chk_rec(chk, 4, bf2f(qp[0]), (q1 * cc - q2 * sn) * MLA_QSCALE, 2e-2f, 1e-2f); chk_rec(chk, 4, bf2f(qp[1]), (q2 * cc + q1 * sn) * MLA_QSCALE, 2e-2f, 1e-2f); } }
        { const int d = (h2 >> 16) % 256; float kv = 0.f; for (int k = lane; k < KVL; k += 64) kv += bf2f(CKVN[(size_t)m * KVL + k]) * bfr(w_ukv[(size_t)k * NKV + h * 256 + d]); kv = wave_sum(kv);
          const float got = d < 128 ? bf2f(KM[((size_t)(b * 8 + h) * LPB + pos) * 192 + d]) : bf2f(VM[((size_t)(b * 8 + h) * LPB + pos) * 128 + d - 128]);
          if (lane == 0) chk_rec(chk, 4, got, kv, 2e-2f, 2e-2f); }
    } else if (stage == 5 || stage == 6) {
        if (m >= MMAIN) b = 0;
        const bool diff = stage == 6; const int dqk = diff ? 128 : 192; const int hx = h1 % 8;
        const bf16_t* Q = diff ? QD + ((size_t)(b * 8 + hx) * LPB + pos) * 128 : QM + ((size_t)(b * 8 + hx) * LPB + pos) * 192;
        const bf16_t* K = diff ? KD + (size_t)(b * 8 + hx) * LPB * 128 : KM + (size_t)(b * 8 + hx) * LPB * 192;
        float mx = -INFINITY;
        for (int k = lane; k <= pos; k += 64) { float sc = 0.f; for (int d = 0; d < dqk; ++d) sc += bf2f(Q[d]) * bf2f(K[(size_t)k * dqk + d]);
            if (diff) { const int n = pos - k; int bk = n; if (n >= 16) { bk = 16 + (int)(logf((float)n / 16.f) / logf(8.f) * 16.f); if (bk > 31) bk = 31; } sc += rel_bias[bk * 8 + hx] * LOG2E; }
            pbuf[k] = sc; mx = fmaxf(mx, sc); }
        mx = wave_max(mx); float l = 0.f;
        for (int k = lane; k <= pos; k += 64) { const float p = exp2f(pbuf[k] - mx); pbuf[k] = p; l += p; } l = wave_sum(l); __syncthreads();
        if (!diff) { const bf16_t* V = VM + (size_t)(b * 8 + hx) * LPB * 128;
            for (int c = lane; c < 128; c += 64) { float o = 0.f; for (int k = 0; k <= pos; ++k) o += pbuf[k] * bf2f(V[(size_t)k * 128 + c]); o /= l;
                { const float got = bf2f(CAT[(size_t)m * DM + hx * 128 + c]); chk_rec(chk, m >= MMAIN ? 12 : 5, got, o, 3e-2f, 5e-3f); if (!(fabsf(got) < 1e30f)) atomicMax(chk + 14, 0x7f000000u); if (m < MMAIN) chk_rec(chk, 16, got, o, 1.5f, 0.25f); } } }
        else { const int hd = hx >> 1;
            for (int c = lane; c < 256; c += 64) { const bf16_t* V = VD + (size_t)(b * 8 + hd * 2 + (c >> 7)) * LPB * 128; float o = 0.f; for (int k = 0; k <= pos; ++k) o += pbuf[k] * bf2f(V[(size_t)k * 128 + (c & 127)]); o /= l;
                { const float got = DP[(size_t)m * DM + hx * 256 + c]; chk_rec(chk, m >= MMAIN ? 13 : 6, got, o, 3e-2f, 5e-3f); if (!(fabsf(got) < 1e30f)) atomicMax(chk + 15, 0x7f000000u); if (m < MMAIN) chk_rec(chk, 17, got, o, 1.5f, 0.25f); } } }
    } else if (stage == 7) {
        const float* lq1 = a.in[11]; const float* lk1 = a.in[12]; const float* lq2 = a.in[13]; const float* lk2 = a.in[14];
        float s1 = 0.f, s2 = 0.f; for (int k = lane; k < 128; k += 64) { s1 += lq1[k] * lk1[k]; s2 += lq2[k] * lk2[k]; } s1 = wave_sum(s1); s2 = wave_sum(s2); const float lam = expf(s1) - expf(s2) + LAM_INIT;
        const int h = h1 % 4; float ss = 0.f; for (int c = lane; c < 256; c += 64) { const float d = DP[(size_t)m * DM + (h * 2) * 256 + c] - lam * DP[(size_t)m * DM + (h * 2 + 1) * 256 + c]; ss += d * d; } ss = wave_sum(ss);
        const int c = h2 % 256; const float d = DP[(size_t)m * DM + (h * 2) * 256 + c] - lam * DP[(size_t)m * DM + (h * 2 + 1) * 256 + c];
        if (lane == 0) chk_rec(chk, 7, bf2f(CAT[(size_t)m * DM + 1024 + h * 256 + c]), d * rsqrtf(ss / 256.f + EPS) * g_sub[c] * 0.8f, 1e-2f, 1e-3f);
    } else if (stage == 8) {
        const int n = h1 % DM; float d = 0.f; for (int k = lane; k < DM; k += 64) d += bf2f(CAT[(size_t)m * DM + k]) * bfr(w_o[(size_t)k * DM + n]); d = wave_sum(d);
        if (lane == 0) chk_rec(chk, 8, AO[(size_t)m * DM + n], d, 2e-2f, 2e-2f);
    } else if (stage == 9) {
        float ss = 0.f; for (int k = lane; k < DM; k += 64) { const float v = AO[(size_t)m * DM + k]; ss += v * v; } ss = wave_sum(ss); const float rs1 = rsqrtf(ss / DM + EPS);
        float s2 = 0.f; for (int k = lane; k < DM; k += 64) { const float hv = row0[k] + AO[(size_t)m * DM + k] * rs1 * g_attn_post[k]; s2 += hv * hv; } s2 = wave_sum(s2); const float rs2 = rsqrtf(s2 / DM + EPS);
        const int c = h1 % DM; const float hv = row0[c] + AO[(size_t)m * DM + c] * rs1 * g_attn_post[c];
        if (lane == 0) { chk_rec(chk, 9, HB[(size_t)m * DM + c], hv, 1e-4f, 1e-4f); chk_rec(chk, 9, bf2f(N2[((size_t)b * LPB + pos) * DM + c]), hv * rs2 * g_ffn_pre[c], 1e-2f, 1e-3f); }
    } else if (stage == 10) {
        if (m >= MMAIN) { m = h0 % MMAIN; b = m >> 12; pos = NMETA + (m & 4095); }
        const int c = h1 % DFF; float up[2][3];
        for (int gv = 0; gv < 2; ++gv) for (int j = 0; j < 3; ++j) { const int col = gv * DFF + c; const bf16_t* nr = N2 + ((size_t)b * LPB + pos - 2 + j) * DM; float d = 0.f;
            for (int k = lane; k < DM; k += 64) d += bf2f(nr[k]) * bfr(w_up[(size_t)k * NUP + col]); up[gv][j] = wave_sum(d); }
        float cv[2]; for (int gv = 0; gv < 2; ++gv) { const int col = gv * DFF + c; cv[gv] = conv_b[col] + conv_w[col] * up[gv][0] + conv_w[NUP + col] * up[gv][1] + conv_w[2 * NUP + col] * up[gv][2]; }
        const float want = cv[0] / (1.f + expf(-cv[0])) * cv[1];
        if (lane == 0) chk_rec(chk, 10, bf2f(ACT[(size_t)m * DFF + c]), want, 3e-2f, 3e-2f);
    } else if (stage == 11) {
        if (m >= MMAIN) m = h0 % MMAIN;
        const int n = h1 % DM; float d = 0.f; for (int k = lane; k < DFF; k += 64) d += bf2f(ACT[(size_t)m * DFF + k]) * bfr(w_down[(size_t)k * DM + n]); d = wave_sum(d);
        if (lane == 0) chk_rec(chk, 11, FB[(size_t)m * DM + n], d, 2e-2f, 2e-2f);
    }
}
__global__ void __launch_bounds__(64) naive_attn(CArgs a) {
    const int lane = threadIdx.x; unsigned char* ws = a.ws; const float* rel_bias = a.in[2];
    const bf16_t* QD = (const bf16_t*)(ws + WS_QD); const bf16_t* KD = (const bf16_t*)(ws + WS_KD); const bf16_t* VD = (const bf16_t*)(ws + WS_VD);
    const bf16_t* QM = (const bf16_t*)(ws + WS_QM); const bf16_t* KM = (const bf16_t*)(ws + WS_KM); const bf16_t* VM = (const bf16_t*)(ws + WS_VM);
    bf16_t* CAT = (bf16_t*)(ws + WS_CAT); float* DP = (float*)(ws + WS_DP);
    __shared__ float pbuf[LREAL + 64];
    const int m = blockIdx.x / 16, task = blockIdx.x % 16; const bool diff = task >= 8; const int hx = task & 7, dqk = diff ? 128 : 192;
    int b, pos; if (m < MMAIN) { b = m >> 12; pos = NMETA + (m & 4095); } else { b = 0; pos = m - MMAIN; }
    const bf16_t* Q = diff ? QD + ((size_t)(b * 8 + hx) * LPB + pos) * 128 : QM + ((size_t)(b * 8 + hx) * LPB + pos) * 192;
    const bf16_t* K = diff ? KD + (size_t)(b * 8 + hx) * LPB * 128 : KM + (size_t)(b * 8 + hx) * LPB * 192;
    float mx = -INFINITY;
    for (int k = lane; k <= pos; k += 64) { float sc = 0.f; for (int d = 0; d < dqk; ++d) sc += bf2f(Q[d]) * bf2f(K[(size_t)k * dqk + d]);
        if (diff) { const int n = pos - k; int bk = n; if (n >= 16) { bk = 16 + (int)(logf((float)n / 16.f) / logf(8.f) * 16.f); if (bk > 31) bk = 31; } sc += rel_bias[bk * 8 + hx] * LOG2E; }
        pbuf[k] = sc; mx = fmaxf(mx, sc); }
    mx = wave_max(mx); float l = 0.f;
    for (int k = lane; k <= pos; k += 64) { const float p = exp2f(pbuf[k] - mx); pbuf[k] = p; l += p; } l = wave_sum(l); __syncthreads();
    if (!diff) { const bf16_t* V = VM + (size_t)(b * 8 + hx) * LPB * 128;
        for (int c = lane; c < 128; c += 64) { float o = 0.f; for (int k = 0; k <= pos; ++k) o += pbuf[k] * bf2f(V[(size_t)k * 128 + c]); CAT[(size_t)m * DM + hx * 128 + c] = (bf16_t)f2bf(o / l); } }
    else { const int hd = hx >> 1;
        for (int c = lane; c < 256; c += 64) { const bf16_t* V = VD + (size_t)(b * 8 + hd * 2 + (c >> 7)) * LPB * 128; float o = 0.f; for (int k = 0; k <= pos; ++k) o += pbuf[k] * bf2f(V[(size_t)k * 128 + (c & 127)]); DP[(size_t)m * DM + hx * 256 + c] = o / l; } }
}
__global__ void __launch_bounds__(256) chk_poison(float* out, int n, const unsigned* chk) {
    int first = 0, mask = 0;
    for (int k = 1; k <= 13; ++k) if (k != 5 && k != 6 && __uint_as_float(chk[k]) > 1.f && first == 0) first = k;
    const int ids[6] = {5, 6, 14, 15, 16, 17};
    for (int i = 0; i < 6; ++i) if (__uint_as_float(chk[ids[i]]) > 1.f) mask |= 1 << i;
    if (first == 0 && mask == 0) return;
    const float c = sqrtf(3.f * exp2f((float)first));
    for (int i = blockIdx.x * 256 + threadIdx.x; i < n; i += gridDim.x * 256) { if (i == 12345) { if (mask) out[i] = 100.f + 10.f * mask; } else if (first) out[i] = c; }
}
#endif

extern "C" void kernel_launch(void* const* d_in, const int* in_sizes, int n_in, void* d_out, int out_size, void* d_ws, size_t ws_size, hipStream_t stream) {
    static int grid = 0;
    if (grid == 0) {
        if (n_in != 22 || in_sizes[0] != MMAIN * DM || out_size != MMAIN * DM || ws_size < WS_END) {
            fprintf(stderr, "kernel_launch: unexpected shapes: n_in %d in0 %d out %d ws %zu (need %zu)\n", n_in, n_in > 0 ? in_sizes[0] : -1, out_size, ws_size, (size_t)WS_END); grid = -1; return; }
        int dev = 0, cus = 0;
        if (hipGetDevice(&dev) != hipSuccess || hipDeviceGetAttribute(&cus, hipDeviceAttributeMultiprocessorCount, dev) != hipSuccess) { grid = -1; return; }
        if (hipFuncSetAttribute((const void*)hymba_fwd, hipFuncAttributeMaxDynamicSharedMemorySize, LDS_BYTES) != hipSuccess) { fprintf(stderr, "kernel_launch: hipFuncSetAttribute failed\n"); grid = -1; return; }
        int per_cu = 0; (void)hipOccupancyMaxActiveBlocksPerMultiprocessor(&per_cu, (const void*)hymba_fwd, 512, LDS_BYTES); (void)hipGetLastError();
        grid = cus;
    }
    if (grid < 0) return;
    (void)hipMemsetAsync((char*)d_ws + WS_CTL, 0, CTL_ZERO_BYTES, stream);
    Args a{};
    for (int i = 0; i < 22; ++i) a.in[i] = (const float*)d_in[i];
    a.out = (float*)d_out; a.ws = (unsigned char*)d_ws;
#if !DEBUG_CHECK
#if MK_ONE_LAUNCH
    a.ph_lo = 0; a.ph_hi = 11;
    hipLaunchKernelGGL(hymba_fwd, dim3(grid), dim3(512), LDS_BYTES, stream, a);
#else
    for (int p = 0; p < 11; ++p) { a.ph_lo = p; a.ph_hi = p + 1; hipLaunchKernelGGL(hymba_fwd, dim3(grid), dim3(512), LDS_BYTES, stream, a); }
#endif
#else
    CArgs c{}; for (int i = 0; i < 22; ++i) c.in[i] = (const float*)d_in[i]; c.out = (float*)d_out; c.ws = (unsigned char*)d_ws;
    static const int stage_after_phase[12] = {0, 0, 1, 2, 3, 4, 4, 5, 6, 7, 8, 9};
    int done = -1;
    for (int k = 1; k <= 11; ++k) {
        for (int p = done + 1; p <= stage_after_phase[k]; ++p) { a.ph_lo = p; a.ph_hi = p + 1; hipLaunchKernelGGL(hymba_fwd, dim3(grid), dim3(512), LDS_BYTES, stream, a); }
        if (stage_after_phase[k] > done) done = stage_after_phase[k];
        hipLaunchKernelGGL(chk_kernel, dim3(k == 5 || k == 6 ? 192 : 768), dim3(64), 0, stream, c, k, 0);
        if (k == 6) hipLaunchKernelGGL(naive_attn, dim3((MMAIN + NMETA) * 16), dim3(64), 0, stream, c);
    }
    a.ph_lo = 10; a.ph_hi = 11; hipLaunchKernelGGL(hymba_fwd, dim3(grid), dim3(512), LDS_BYTES, stream, a);
    hipLaunchKernelGGL(chk_poison, dim3(1024), dim3(256), 0, stream, (float*)d_out, out_size, (const unsigned*)((char*)d_ws + WS_CHK));
#endif
    const hipError_t le = hipPeekAtLastError();
    if (le != hipSuccess) fprintf(stderr, "kernel_launch: launch failed: %s\n", hipGetErrorName(le));
}
```

```cpp
#include <hip/hip_runtime.h>
#include <hip/hip_bf16.h>
#include <cstdio>
#include <cstdint>
#include <cmath>

#ifndef MK_ONE_LAUNCH
#define MK_ONE_LAUNCH 1
#endif
#ifndef DEBUG_CHECK
#define DEBUG_CHECK 0
#endif

#define LAS __attribute__((address_space(3)))
#define GAS __attribute__((address_space(1)))
typedef unsigned short bf16_t;
typedef short bf16x8 __attribute__((ext_vector_type(8)));
typedef short s16x4 __attribute__((ext_vector_type(4)));
typedef float f32x4 __attribute__((ext_vector_type(4)));
typedef float f32x2 __attribute__((ext_vector_type(2)));
typedef float f32x16 __attribute__((ext_vector_type(16)));
typedef unsigned u32x4 __attribute__((ext_vector_type(4)));
typedef unsigned u32x2 __attribute__((ext_vector_type(2)));

constexpr int DM = 2048, SEQ = 4096, NMETA = 16, LREAL = SEQ + NMETA  , LPB = 4352  ;
constexpr int MMAIN = 2 * SEQ  , MR = 8448  ;
constexpr int DIN = 3904, NP1 = 4096, DLAT = 1024;
constexpr int QL = 512, KVL = 256, NQM = 1536, NKV = 2048;
constexpr int DFF = 5632, NUP = 2 * DFF;
constexpr float EPS = 1e-6f;
constexpr float LOG2E = 1.4426950408889634f;
constexpr float MLA_QSCALE = 0.07216878364870322f * LOG2E;
constexpr float DIFF_QSCALE = 0.08838834764831845f * LOG2E;
constexpr float LAM_INIT = 0.2f;

constexpr size_t MiB = 1u << 20;
constexpr size_t WS_CTL = 0, CTL_ZERO_BYTES = 1 * MiB;
constexpr size_t WS_CS = 1 * MiB;
constexpr size_t WS_BT = 3 * MiB;
constexpr size_t WS_W1 = 4 * MiB;
constexpr size_t WS_WUQ = 20 * MiB;
constexpr size_t WS_WUKV = 22 * MiB;
constexpr size_t WS_WO = 23 * MiB;
constexpr size_t WS_WUP = 31 * MiB;
constexpr size_t WS_WDN = 75 * MiB;
constexpr size_t WS_A = 97 * MiB;
constexpr size_t WS_NR = WS_A + 0 * MiB;
constexpr size_t WS_LAT = WS_A + 33 * MiB;
constexpr size_t WS_CQN = WS_A + 50 * MiB;
constexpr size_t WS_CKVN = WS_A + 59 * MiB;
constexpr size_t WS_QD = WS_A + 64 * MiB;
constexpr size_t WS_KD = WS_A + 81 * MiB;
constexpr size_t WS_VD = WS_A + 98 * MiB;
constexpr size_t WS_QM = WS_A + 115 * MiB;
constexpr size_t WS_KM = WS_A + 141 * MiB;
constexpr size_t WS_VM = WS_A + 167 * MiB;
constexpr size_t WS_CAT = WS_A + 0 * MiB;
constexpr size_t WS_DP = WS_A + 184 * MiB;
constexpr size_t WS_AO = WS_A + 33 * MiB;
constexpr size_t WS_H = WS_A + 99 * MiB;
constexpr size_t WS_N2 = WS_A + 165 * MiB;
constexpr size_t WS_ACT = WS_A + 0 * MiB;
constexpr size_t WS_F = WS_A + 165 * MiB;
constexpr size_t WS_END = WS_A + 250 * MiB;
constexpr size_t WS_CHK = 512 * 1024;
constexpr int CW_BAR = 4096;
constexpr int CW_QUEUE = 16384;

constexpr int RING_BYTES = 131072, LDSCTL_OFF = RING_BYTES, MISC_OFF = LDSCTL_OFF + 320, XCONV_OFF = 133120, LDS_BYTES = 147456;

#define RLX_AGENT __ATOMIC_RELAXED, __HIP_MEMORY_SCOPE_AGENT
#define LDS_WAIT() asm volatile("s_waitcnt lgkmcnt(0)" ::: "memory")
#define VM_WAIT() asm volatile("s_waitcnt vmcnt(0)" ::: "memory")
__host__ __device__ __forceinline__ unsigned f2bf(float f) { unsigned u = __builtin_bit_cast(unsigned, f); return (u + 0x7fffu + ((u >> 16) & 1u)) >> 16; }
__host__ __device__ __forceinline__ float bf2f(unsigned h) { return __builtin_bit_cast(float, (h & 0xffffu) << 16); }
__device__ __forceinline__ unsigned pk2(float lo, float hi) { return f2bf(lo) | (f2bf(hi) << 16); }
__device__ __forceinline__ unsigned cvt_pk_bf16(float lo, float hi) { unsigned r; asm volatile("v_cvt_pk_bf16_f32 %0, %1, %2" : "=v"(r) : "v"(lo), "v"(hi)); return r; }
__device__ __forceinline__ float wave_sum(float v) {
#pragma unroll
    for (int o = 1; o < 64; o <<= 1) v += __shfl_xor(v, o);
    return v;
}
__device__ __forceinline__ float wave_max(float v) {
#pragma unroll
    for (int o = 1; o < 64; o <<= 1) v = fmaxf(v, __shfl_xor(v, o));
    return v;
}
__device__ __forceinline__ int row_dests(int pm, int lr, int& b0, int& pos) {
    if (pm < 32) { b0 = pm >> 4; pos = NMETA + (pm & 15) * 256 + lr; return 1; }
    b0 = 0; pos = lr; return (pm == 32 && lr < NMETA) ? 2 : 0;
}
__host__ __device__ __forceinline__ int map_win(int n) { if (n < 768) return n; if (n < 832) { const int i = n - 768; return 768 + 2 * (i & 31) + (i >> 5); } return n + 192; }
__host__ __device__ __forceinline__ int map_wuq(int n) { const int h = n / 192, d = n - 192 * h; if (d < 128) return n; const int i = d - 128; return h * 192 + 128 + 2 * (i & 31) + (i >> 5); }
__host__ __device__ __forceinline__ int map_wup(int n) { if (n < DFF) return (n >> 7) * 256 + (n & 127); const int m = n - DFF; return (m >> 7) * 256 + 128 + (m & 127); }

namespace pg8 {
constexpr int BM = 256, BK = 64, HALF = 128, HTB = HALF * BK * 2, STAGE_BYTES = 8 * HTB, NXCD = 8, WGM = 8;
__host__ __device__ __forceinline__ int lds_byte(int r, int c) { const int st = (r >> 4) * 2 + (c >> 5), rr = r & 15, cc = c & 31, ob = rr * 64 + cc * 2; return st * 1024 + (ob ^ (((ob >> 9) & 1) << 5)); }
__host__ __device__ __forceinline__ void stage_rc(int b, int& R, int& C) { const int st = b / 1024, sb = b % 1024, swz = sb ^ (((sb >> 9) & 1) << 5); R = (st >> 1) * 16 + swz / 64; C = (st & 1) * 32 + (swz % 64) / 2; }
__host__ __device__ __forceinline__ int perm32(int rho) { const int n = rho >> 4, i = rho & 15; return 8 * (i >> 2) + 4 * n + (i & 3); }

struct Unit { int pm, pn, arow; };
struct Gemm { const bf16_t* A; const bf16_t* Bt; int lda; int K; };

template <int MODE> struct StaticOrder {
    int nM, nN, nwg, G, c;
    __device__ void init(int nM_, int nN_, int G_, int c_) { nM = nM_; nN = nN_; nwg = nM * nN; G = G_; c = c_; }
    __device__ bool next(int i, Unit& u) const {
        const long L = (long)i * G + c; if (L >= nwg) return false;
        int wgid = (int)L; { const int q = nwg / NXCD, r = nwg % NXCD, xcd = wgid % NXCD, off = wgid / NXCD; wgid = (xcd < r ? xcd * (q + 1) : r * (q + 1) + (xcd - r) * q) + off; }
        const int nig = WGM * nN, gid = wgid / nig, fm = gid * WGM, gsz = (nM - fm) < WGM ? (nM - fm) : WGM;
        u.pm = fm + ((wgid % nig) % gsz); u.pn = (wgid % nig) / gsz;
        if (MODE == 0) u.arow = u.pm * BM; else { const int b = u.pm / 17, i2 = u.pm - 17 * b; u.arow = b * LPB + 14 + 254 * i2; }
        return true;
    }
};

__device__ __forceinline__ u32x4 pack8(const f32x4 v0, const f32x4 v1) { u32x4 w; w.x = cvt_pk_bf16(v0[0], v0[1]); w.y = cvt_pk_bf16(v0[2], v0[3]); w.z = cvt_pk_bf16(v1[0], v1[1]); w.w = cvt_pk_bf16(v1[2], v1[3]); return w; }

struct EpiG1 {
    static constexpr bool PERM = true;
    bf16_t* lat; bf16_t* qd; bf16_t* kd; bf16_t* vd; float qscale;
    __device__ __forceinline__ void operator()(f32x4 (&acc)[2][2][4][2], const Unit& u, int wr, int wc, int fr_in, int fq) const {
        int fr = fr_in; asm volatile("" : "+v"(fr));
        const int colin = wc * 32 + 8 * fq;
#pragma unroll
        for (int bj = 0; bj < 2; ++bj) {
            const int q = 2 * u.pn + bj; float sc = 1.f; bf16_t* base;
            if (q < 8) base = lat + 128 * q + colin;
            else if (q < 16) { base = qd + (size_t)(q - 8) * LPB * 128 + colin; sc = qscale; }
            else if (q < 24) base = kd + (size_t)(q - 16) * LPB * 128 + colin;
            else base = vd + (size_t)(q - 24) * LPB * 128 + colin;
#pragma unroll
            for (int ai = 0; ai < 2; ++ai)
#pragma unroll
                for (int m = 0; m < 4; ++m) {
                    const int lr = ai * HALF + wr * 64 + m * 16 + fr;
                    const u32x4 w = pack8(acc[ai][bj][m][0] * sc, acc[ai][bj][m][1] * sc);
                    if (q < 8) { *(u32x4*)(base + (size_t)(u.pm * BM + lr) * DLAT) = w; }
                    else { int b0, pos; const int nb = row_dests(u.pm, lr, b0, pos);
                        for (int k = 0; k < nb; ++k) *(u32x4*)(base + ((size_t)(b0 + k) * 8 * LPB + pos) * 128) = w; }
                }
        }
    }
};
struct EpiQm {
    static constexpr bool PERM = true;
    bf16_t* qm; const float* cs; float qscale;
    __device__ __forceinline__ void operator()(f32x4 (&acc)[2][2][4][2], const Unit& u, int wr, int wc, int fr_in, int fq) const {
        int fr = fr_in; asm volatile("" : "+v"(fr));
#pragma unroll
        for (int bj = 0; bj < 2; ++bj) {
            const int c0 = u.pn * BM + bj * HALF + wc * 32 + 8 * fq, h = c0 / 192, d = c0 - 192 * h; const bool rope = d >= 128; const int i0 = (d - 128) >> 1;
#pragma unroll
            for (int ai = 0; ai < 2; ++ai)
#pragma unroll
                for (int m = 0; m < 4; ++m) {
                    const int lr = ai * HALF + wr * 64 + m * 16 + fr; int b0, pos; const int nb = row_dests(u.pm, lr, b0, pos);
                    f32x4 v0 = acc[ai][bj][m][0], v1 = acc[ai][bj][m][1];
                    if (rope && nb) { const f32x4 t0 = *(const f32x4*)(cs + ((size_t)pos * 32 + i0) * 2), t1 = *(const f32x4*)(cs + ((size_t)pos * 32 + i0 + 2) * 2);
                        const f32x4 a0 = v0, a1 = v1;
                        v0[0] = a0[0] * t0[0] - a0[1] * t0[1]; v0[1] = a0[1] * t0[0] + a0[0] * t0[1]; v0[2] = a0[2] * t0[2] - a0[3] * t0[3]; v0[3] = a0[3] * t0[2] + a0[2] * t0[3];
                        v1[0] = a1[0] * t1[0] - a1[1] * t1[1]; v1[1] = a1[1] * t1[0] + a1[0] * t1[1]; v1[2] = a1[2] * t1[2] - a1[3] * t1[3]; v1[3] = a1[3] * t1[2] + a1[2] * t1[3]; }
                    const u32x4 w = pack8(v0 * qscale, v1 * qscale);
                    for (int k = 0; k < nb; ++k) *(u32x4*)(qm + ((size_t)((b0 + k) * 8 + h) * LPB + pos) * 192 + d) = w;
                    asm volatile("" ::: "memory");
                }
        }
    }
};
struct EpiKv {
    static constexpr bool PERM = true;
    bf16_t* km; bf16_t* vm;
    __device__ __forceinline__ void operator()(f32x4 (&acc)[2][2][4][2], const Unit& u, int wr, int wc, int fr_in, int fq) const {
        int fr = fr_in; asm volatile("" : "+v"(fr));
        const int colin = wc * 32 + 8 * fq, h = u.pn;
#pragma unroll
        for (int ai = 0; ai < 2; ++ai)
#pragma unroll
            for (int m = 0; m < 4; ++m) {
                const int lr = ai * HALF + wr * 64 + m * 16 + fr; int b0, pos; const int nb = row_dests(u.pm, lr, b0, pos);
                const u32x4 w0 = pack8(acc[ai][0][m][0], acc[ai][0][m][1]), w1 = pack8(acc[ai][1][m][0], acc[ai][1][m][1]);
                for (int k = 0; k < nb; ++k) { const unsigned row = (unsigned)((b0 + k) * 8 + h) * LPB + pos;
                    *(u32x4*)(km + (size_t)row * 192 + colin) = w0; *(u32x4*)(vm + (size_t)row * 128 + colin) = w1; }
                asm volatile("" ::: "memory");
            }
    }
};
struct EpiF32 {
    static constexpr bool PERM = false;
    float* out; int ldc;
    __device__ __forceinline__ void operator()(f32x4 (&acc)[2][2][4][2], const Unit& u, int wr, int wc, int fr_in, int fq) const {
        int fr = fr_in; asm volatile("" : "+v"(fr));
        const int col0 = u.pn * BM + wc * 32 + 4 * fq;
#pragma unroll
        for (int ai = 0; ai < 2; ++ai)
#pragma unroll
            for (int m = 0; m < 4; ++m) { float* rowp = out + (size_t)(u.pm * BM + ai * HALF + wr * 64 + m * 16 + fr) * ldc + col0;
#pragma unroll
                for (int bj = 0; bj < 2; ++bj)
#pragma unroll
                    for (int n = 0; n < 2; ++n) *(f32x4*)(rowp + bj * HALF + n * 16) = acc[ai][bj][m][n]; }
    }
};
__device__ __forceinline__ float ror1(float v) { return __builtin_bit_cast(float, __builtin_amdgcn_update_dpp(0, __builtin_bit_cast(int, v), 0x121, 0xf, 0xf, false)); }
__device__ __forceinline__ float ror2(float v) { return __builtin_bit_cast(float, __builtin_amdgcn_update_dpp(0, __builtin_bit_cast(int, v), 0x122, 0xf, 0xf, false)); }
struct EpiConv {
    static constexpr bool PERM = true;
    bf16_t* act; const float* cw; const float* cb; LAS float* X;
    __device__ __forceinline__ void operator()(f32x4 (&acc)[2][2][4][2], const Unit& u, int wr, int wc, int fr_in, int fq) const {
        int fr = fr_in; asm volatile("" : "+v"(fr));
        const int colx = wc * 32 + 8 * fq;
        if (fr >= 14) {
#pragma unroll
            for (int ai = 0; ai < 2; ++ai)
#pragma unroll
                for (int bj = 0; bj < 2; ++bj)
#pragma unroll
                    for (int n = 0; n < 2; ++n) *(LAS f32x4*)(X + (((2 * ai + wr) * 2 + (fr - 14)) * 256 + bj * HALF + colx + 4 * n)) = acc[ai][bj][3][n];
        }
        asm volatile("s_waitcnt lgkmcnt(0)" ::: "memory"); __builtin_amdgcn_s_barrier(); asm volatile("" ::: "memory");
#pragma unroll
        for (int bj = 0; bj < 2; ++bj)
#pragma unroll
            for (int n = 0; n < 2; ++n) {
                const int gcol = (bj ? DFF : 0) + u.pn * HALF + colx + 4 * n;
                const f32x4 w0 = *(const f32x4*)(cw + gcol), w1 = *(const f32x4*)(cw + NUP + gcol), w2 = *(const f32x4*)(cw + 2 * NUP + gcol), bb = *(const f32x4*)(cb + gcol);
#pragma unroll
                for (int ai = 0; ai < 2; ++ai) {
                    const int g = 2 * ai + wr;
                    f32x4 x62 = (f32x4){0.f, 0.f, 0.f, 0.f}, x63 = x62;
                    if (g > 0) { x62 = *(const LAS f32x4*)(X + (((g - 1) * 2 + 0) * 256 + bj * HALF + colx + 4 * n)); x63 = *(const LAS f32x4*)(X + (((g - 1) * 2 + 1) * 256 + bj * HALF + colx + 4 * n)); }
                    f32x4 s1, s2;
#pragma unroll
                    for (int e = 0; e < 4; ++e) { s1[e] = ror1(acc[ai][bj][3][n][e]); s2[e] = ror2(acc[ai][bj][3][n][e]); }
#pragma unroll
                    for (int m = 3; m >= 0; --m) {
                        f32x4 q1, q2;
                        if (m > 0) {
#pragma unroll
                            for (int e = 0; e < 4; ++e) { q1[e] = ror1(acc[ai][bj][m - 1][n][e]); q2[e] = ror2(acc[ai][bj][m - 1][n][e]); }
                        } else { q1 = x63; q2 = (fr == 0) ? x62 : x63; }
                        const f32x4 cur = acc[ai][bj][m][n]; f32x4 nw;
#pragma unroll
                        for (int e = 0; e < 4; ++e) { const float p1 = (fr == 0) ? q1[e] : s1[e], p2 = (fr < 2) ? q2[e] : s2[e]; nw[e] = bb[e] + w0[e] * p2 + w1[e] * p1 + w2[e] * cur[e]; }
                        asm volatile("" : "+v"(nw[0]), "+v"(nw[1]), "+v"(nw[2]), "+v"(nw[3]));
                        acc[ai][bj][m][n] = nw; s1 = q1; s2 = q2;
                    }
                    asm volatile("" ::: "memory");
                }
                __builtin_amdgcn_sched_barrier(0);
            }
        const int b = u.pm / 17, i2 = u.pm - 17 * b, p0 = 14 + 254 * i2;
#pragma unroll
        for (int ai = 0; ai < 2; ++ai)
#pragma unroll
            for (int m = 0; m < 4; ++m) {
                const int lr = ai * HALF + wr * 64 + m * 16 + fr, pos = p0 + lr;
                f32x4 o0, o1;
#pragma unroll
                for (int e = 0; e < 4; ++e) { const float g0 = acc[ai][0][m][0][e], g1 = acc[ai][0][m][1][e];
                    o0[e] = g0 * __builtin_amdgcn_rcpf(1.f + __builtin_amdgcn_exp2f(-g0 * LOG2E)) * acc[ai][1][m][0][e];
                    o1[e] = g1 * __builtin_amdgcn_rcpf(1.f + __builtin_amdgcn_exp2f(-g1 * LOG2E)) * acc[ai][1][m][1][e]; }
                if (lr >= 2 && pos < LREAL) *(u32x4*)(act + (size_t)(b * SEQ + pos - NMETA) * DFF + u.pn * HALF + colx) = pack8(o0, o1);
                asm volatile("" ::: "memory");
            }
    }
};

template <class Epi, class Sched, bool ALIGN_EPI>
__device__ __forceinline__ void gemm_phase(LAS unsigned char* lds, const Gemm g, const Sched& S, const Epi& E) {
    int tid_ = threadIdx.x; asm volatile("" : "+v"(tid_));
    const int tid = tid_, wid = __builtin_amdgcn_readfirstlane(tid >> 6), lane = tid & 63, wr = wid >> 2, wc = wid & 3, fr = lane & 15, fq = lane >> 4;
    const int K = g.K, nt = K / BK, lda = g.lda;
    unsigned voffA[2], voffB[2];
#pragma unroll
    for (int i = 0; i < 2; ++i) { int R, C; stage_rc(tid * 16 + i * 8192, R, C); const int Rb = Epi::PERM ? ((R & ~31) + perm32(R & 31)) : R;
        voffA[i] = (unsigned)(R * lda + C) * 2u; voffB[i] = (unsigned)(Rb * K + C) * 2u; }
    const size_t kstep = (size_t)(BK * 2);
    const size_t hstepA = (size_t)HALF * lda * 2, hstepB = (size_t)HALF * K * 2;
    const size_t tstepB = 2 * hstepB;
    const unsigned ldsw = (unsigned)wid * 1024u;
    const int aoff = lds_byte(wr * 64 + fr, fq * 8), boff = lds_byte(wc * 32 + fr, fq * 8);
#define PG8_SA(b, h) (((b) * 2 + (h)) * HTB)
#define PG8_SB(b, h) ((4 + (b) * 2 + (h)) * HTB)
#define PG8_STAGE(bufoff, gbase, voff) do { _Pragma("unroll") for (int _i = 0; _i < 2; ++_i) \
        __builtin_amdgcn_global_load_lds((const unsigned*)((const char*)(gbase) + (voff)[_i]), (LAS unsigned*)(lds + (bufoff) + ldsw + _i * 8192), 16, 0, 0); } while (0)
#define PG8_LDA(dst, b, h) do { _Pragma("unroll") for (int m = 0; m < 4; ++m) _Pragma("unroll") for (int k = 0; k < 2; ++k) dst[m][k] = *(const LAS bf16x8*)(lds + PG8_SA(b, h) + aoff + m * 2048 + k * 1024); } while (0)
#define PG8_LDB(dst, b, h) do { _Pragma("unroll") for (int n = 0; n < 2; ++n) _Pragma("unroll") for (int k = 0; k < 2; ++k) dst[n][k] = *(const LAS bf16x8*)(lds + PG8_SB(b, h) + boff + n * 2048 + k * 1024); } while (0)
#define PG8_MMA(ai, bj, At, Bt) do { __builtin_amdgcn_s_setprio(1); _Pragma("unroll") for (int m = 0; m < 4; ++m) _Pragma("unroll") for (int n = 0; n < 2; ++n) _Pragma("unroll") for (int k = 0; k < 2; ++k) \
        acc[ai][bj][m][n] = __builtin_amdgcn_mfma_f32_16x16x32_bf16(Bt[n][k], At[m][k], acc[ai][bj][m][n], 0, 0, 0); __builtin_amdgcn_s_setprio(0); } while (0)
#define PG8_WAIT_V(n) asm volatile("s_waitcnt vmcnt(" #n ")" ::: "memory")
#define PG8_WAIT_L(n) asm volatile("s_waitcnt lgkmcnt(" #n ")" ::: "memory")
#define PG8_BAR __builtin_amdgcn_s_barrier()
#define PG8_SCHED __builtin_amdgcn_sched_barrier(0)
    Unit cur, nxt; int ui = 0;
    if (!S.next(0, cur)) return;
    f32x4 acc[2][2][4][2];
#pragma unroll
    for (int a = 0; a < 2; ++a)
#pragma unroll
        for (int b = 0; b < 2; ++b)
#pragma unroll
            for (int m = 0; m < 4; ++m)
#pragma unroll
                for (int n = 0; n < 2; ++n) acc[a][b][m][n] = (f32x4){0.f, 0.f, 0.f, 0.f};
    bf16x8 At[4][2], B0[2][2], B1[2][2];
    const char* cA = (const char*)g.A + (size_t)cur.arow * lda * 2; const char* cB = (const char*)g.Bt + (size_t)cur.pn * tstepB;
    PG8_STAGE(PG8_SB(0, 0), cB, voffB); PG8_STAGE(PG8_SB(0, 1), cB + hstepB, voffB); PG8_STAGE(PG8_SA(0, 0), cA, voffA); PG8_STAGE(PG8_SA(0, 1), cA + hstepA, voffA);
    if (wr == 1) PG8_BAR;
    PG8_WAIT_V(2); PG8_BAR;
    PG8_STAGE(PG8_SB(1, 0), cB + kstep, voffB); PG8_STAGE(PG8_SA(1, 0), cA + kstep, voffA); PG8_STAGE(PG8_SB(1, 1), cB + hstepB + kstep, voffB);
    PG8_WAIT_V(6); PG8_BAR;
    for (;;) {
        const bool has_next = S.next(ui + 1, nxt);
        const char* nA = has_next ? (const char*)g.A + (size_t)nxt.arow * lda * 2 : cA; const char* nB = has_next ? (const char*)g.Bt + (size_t)nxt.pn * tstepB : cB;
        for (int t = 0; t < nt; t += 2) {
            const bool last = (t == nt - 2);
            const char* a1 = cA + (size_t)(t + 1) * kstep;
            const char* a2 = last ? nA : cA + (size_t)(t + 2) * kstep; const char* b2 = last ? nB : cB + (size_t)(t + 2) * kstep;
            const char* a3 = a2 + kstep; const char* b3 = b2 + kstep;
            PG8_LDB(B0, 0, 0); PG8_LDB(B1, 0, 1); PG8_SCHED; PG8_LDA(At, 0, 0); PG8_STAGE(PG8_SA(1, 1), a1 + hstepA, voffA);
            PG8_WAIT_V(8); PG8_WAIT_L(0); PG8_BAR; PG8_MMA(0, 0, At, B0); PG8_MMA(0, 1, At, B1); PG8_BAR; PG8_SCHED;
            PG8_LDA(At, 0, 1); PG8_STAGE(PG8_SB(0, 0), b2, voffB); PG8_STAGE(PG8_SB(0, 1), b2 + hstepB, voffB); PG8_STAGE(PG8_SA(0, 0), a2, voffA);
            PG8_WAIT_V(8); PG8_WAIT_L(0); PG8_BAR; PG8_MMA(1, 0, At, B0); PG8_MMA(1, 1, At, B1); PG8_BAR; PG8_SCHED;
            PG8_LDB(B0, 1, 0); PG8_LDB(B1, 1, 1); PG8_SCHED; PG8_LDA(At, 1, 0); PG8_STAGE(PG8_SA(0, 1), a2 + hstepA, voffA);
            PG8_WAIT_V(8); PG8_WAIT_L(0); PG8_BAR; PG8_MMA(0, 0, At, B0); PG8_MMA(0, 1, At, B1); PG8_BAR; PG8_SCHED;
            PG8_LDA(At, 1, 1); PG8_STAGE(PG8_SB(1, 0), b3, voffB); PG8_STAGE(PG8_SB(1, 1), b3 + hstepB, voffB); PG8_STAGE(PG8_SA(1, 0), a3, voffA);
            PG8_WAIT_V(8); PG8_WAIT_L(0); PG8_BAR; PG8_MMA(1, 0, At, B0); PG8_MMA(1, 1, At, B1); PG8_BAR; PG8_SCHED;
        }
        if constexpr (ALIGN_EPI) { if (wr == 0) PG8_BAR; }
        E(acc, cur, wr, wc, fr, fq);
        if (!has_next) break;
#pragma unroll
        for (int a = 0; a < 2; ++a)
#pragma unroll
            for (int b = 0; b < 2; ++b)
#pragma unroll
                for (int m = 0; m < 4; ++m)
#pragma unroll
                    for (int n = 0; n < 2; ++n) acc[a][b][m][n] = (f32x4){0.f, 0.f, 0.f, 0.f};
        cur = nxt; cA = nA; cB = nB; ++ui;
        if constexpr (ALIGN_EPI) { if (wr == 1) PG8_BAR; }
    }
    PG8_WAIT_V(0);
    if constexpr (!ALIGN_EPI) { if (wr == 0) PG8_BAR; }
    PG8_BAR;
#undef PG8_SA
#undef PG8_SB
#undef PG8_STAGE
#undef PG8_LDA
#undef PG8_LDB
#undef PG8_MMA
#undef PG8_WAIT_V
#undef PG8_WAIT_L
#undef PG8_BAR
#undef PG8_SCHED
}
}

namespace att {
constexpr int NW = 8, QBLK = 32, KVBLK = 64, DV = 128;
constexpr int SHM_V = KVBLK * DV * 2;
constexpr int OFF_V = 0, OFF_K = 2 * SHM_V, OFF_WS = OFF_K + 2 * KVBLK * 192 * 2  , OFF_BT = OFF_WS + NW * 64 * 4  , OFF_U = OFF_BT + 1024, OFF_QR = OFF_U + 1024, ATT_LDS = OFF_QR + NW * 4096;
constexpr float THR = 8.f;
#define SBAR() __builtin_amdgcn_sched_barrier(0)
__device__ __forceinline__ int crow(int r, int hi) { return (r & 3) + 8 * (r >> 2) + 4 * hi; }
template <int DQK> __device__ __forceinline__ int kswz(int row) { return DQK == 128 ? (row & 7) : ((row >> 1) & 7); }

__device__ __forceinline__ void partialSM(f32x16& p0, f32x16& p1, float& m_reg, float& alpha) {
    float pmax = p0[0];
#pragma unroll
    for (int r = 1; r < 16; ++r) pmax = fmaxf(pmax, p0[r]);
#pragma unroll
    for (int r = 0; r < 16; ++r) pmax = fmaxf(pmax, p1[r]);
    { auto rr = __builtin_amdgcn_permlane32_swap(__float_as_uint(pmax), __float_as_uint(pmax), false, false);
      pmax = fmaxf(__uint_as_float(rr[0]), __uint_as_float(rr[1])); }
    float mn;
    if (__builtin_expect(__all(pmax - m_reg <= THR), 1)) { mn = m_reg; alpha = 1.f; }
    else { mn = fmaxf(m_reg, pmax); alpha = __builtin_amdgcn_exp2f(m_reg - mn); m_reg = mn; }
#pragma unroll
    for (int r = 0; r < 16; ++r) p0[r] = p0[r] - mn;
#pragma unroll
    for (int r = 0; r < 16; ++r) p1[r] = p1[r] - mn;
#pragma unroll
    for (int r = 0; r < 16; ++r) p0[r] = __builtin_amdgcn_exp2f(p0[r]);
}
__device__ __forceinline__ void finishSM(f32x16& p0, f32x16& p1, float alpha, float& l_reg, bf16x8& pa0, bf16x8& pa1, bf16x8& pa2, bf16x8& pa3) {
#pragma unroll
    for (int r = 0; r < 16; ++r) p1[r] = __builtin_amdgcn_exp2f(p1[r]);
    float ps = 0;
#pragma unroll
    for (int r = 0; r < 16; ++r) ps += p0[r];
#pragma unroll
    for (int r = 0; r < 16; ++r) ps += p1[r];
    { auto rr = __builtin_amdgcn_permlane32_swap(__float_as_uint(ps), __float_as_uint(ps), false, false);
      ps = __uint_as_float(rr[0]) + __uint_as_float(rr[1]); }
    l_reg = l_reg * alpha + ps;
#define PK4(P, BASE, OUT) do { unsigned a0 = cvt_pk_bf16(P[BASE + 0], P[BASE + 1]), a1 = cvt_pk_bf16(P[BASE + 2], P[BASE + 3]);   \
    unsigned b0 = cvt_pk_bf16(P[BASE + 4], P[BASE + 5]), b1 = cvt_pk_bf16(P[BASE + 6], P[BASE + 7]);                              \
    auto r0 = __builtin_amdgcn_permlane32_swap(a0, b0, false, false); auto r1 = __builtin_amdgcn_permlane32_swap(a1, b1, false, false); \
    u32x4 w = {r0[0], r1[0], r0[1], r1[1]}; OUT = __builtin_bit_cast(bf16x8, w); } while (0)
    PK4(p0, 0, pa0); PK4(p0, 8, pa1); PK4(p1, 0, pa2); PK4(p1, 8, pa3);
#undef PK4
}
template <int DQK> __device__ __forceinline__ void qkt(f32x16& p0, f32x16& p1, const LAS char* Ks, const bf16x8* qr, const LAS char* qrope, int r32, int hi, float cinit) {
#pragma unroll
    for (int r = 0; r < 16; ++r) { p0[r] = cinit; p1[r] = cinit; }
    const int sw = kswz<DQK>(r32);
    const LAS char* k0 = Ks + r32 * (DQK * 2); const LAS char* k1 = Ks + (32 + r32) * (DQK * 2);
#pragma unroll
    for (int d0 = 0; d0 < DQK / 16; ++d0) { const int off = ((2 * d0 + hi) ^ sw) << 4;
        const bf16x8 b0 = *(const LAS bf16x8*)(k0 + off), b1 = *(const LAS bf16x8*)(k1 + off);
        bf16x8 qv; if (d0 < 8) qv = qr[d0 < 8 ? d0 : 0]; else qv = *(const LAS bf16x8*)(qrope + r32 * 128 + (((2 * (d0 - 8) + hi) ^ ((r32 >> 1) & 7)) << 4));
        p0 = __builtin_amdgcn_mfma_f32_32x32x16_bf16(b0, qv, p0, 0, 0, 0);
        p1 = __builtin_amdgcn_mfma_f32_32x32x16_bf16(b1, qv, p1, 0, 0, 0);
        if ((d0 & 3) == 3) SBAR(); }
}
__device__ __forceinline__ int v_st(int k, int c) { const int kk = (k & ~0xC) | ((k & 4) << 1) | ((k & 8) >> 1); return ((kk >> 3) * 4 + (c >> 5)) * 512 + ((kk & 7) * 32 + (c & 31)) * 2; }
__device__ __forceinline__ int v_rd_base(int lane) { return ((lane & 3) << 3) | (((lane >> 2) & 3) << 6) | (((lane >> 4) & 1) << 5) | (((lane >> 5) & 1) << 8); }
constexpr int v_rd_off(int d0, int ks, int half) { return d0 * 512 + ks * 4096 + half * 2048; }
template <int OFF> __device__ __forceinline__ s16x4 tr_read(int vb) { s16x4 r; asm volatile("ds_read_b64_tr_b16 %0, %1 offset:%2" : "=&v"(r) : "v"(vb), "i"(OFF) : "memory"); return r; }
template <int D0> __device__ __forceinline__ void pv_one(f32x16& od, int vb, bf16x8 pa0, bf16x8 pa1, bf16x8 pa2, bf16x8 pa3) {
    const s16x4 l0 = tr_read<v_rd_off(D0, 0, 0)>(vb), h0 = tr_read<v_rd_off(D0, 0, 1)>(vb), l1 = tr_read<v_rd_off(D0, 1, 0)>(vb), h1 = tr_read<v_rd_off(D0, 1, 1)>(vb);
    const s16x4 l2 = tr_read<v_rd_off(D0, 2, 0)>(vb), h2 = tr_read<v_rd_off(D0, 2, 1)>(vb), l3 = tr_read<v_rd_off(D0, 3, 0)>(vb), h3 = tr_read<v_rd_off(D0, 3, 1)>(vb);
    asm volatile("s_waitcnt lgkmcnt(0)" ::: "memory"); SBAR();
#define PK(L, H) (bf16x8){L[0], L[1], L[2], L[3], H[0], H[1], H[2], H[3]}
    od = __builtin_amdgcn_mfma_f32_32x32x16_bf16(pa0, PK(l0, h0), od, 0, 0, 0);
    od = __builtin_amdgcn_mfma_f32_32x32x16_bf16(pa1, PK(l1, h1), od, 0, 0, 0);
    od = __builtin_amdgcn_mfma_f32_32x32x16_bf16(pa2, PK(l2, h2), od, 0, 0, 0);
    od = __builtin_amdgcn_mfma_f32_32x32x16_bf16(pa3, PK(l3, h3), od, 0, 0, 0);
#undef PK
}
__device__ __forceinline__ void pv_d0(f32x16* o, int vb, bf16x8 pa0, bf16x8 pa1, bf16x8 pa2, bf16x8 pa3) {
    pv_one<0>(o[0], vb, pa0, pa1, pa2, pa3); pv_one<1>(o[1], vb, pa0, pa1, pa2, pa3); pv_one<2>(o[2], vb, pa0, pa1, pa2, pa3); pv_one<3>(o[3], vb, pa0, pa1, pa2, pa3);
}
template <bool DIFF> __device__ __forceinline__ void mask_tile(f32x16& p0, f32x16& p1, int t, int qpos, int hi, const LAS float* bt) {
    const float NEG = -INFINITY; const int kb = 64 * t + 4 * hi;
#pragma unroll
    for (int r = 0; r < 16; ++r) { const int kv = kb + (r & 3) + 8 * (r >> 2);
        if (DIFF) { const int d0 = qpos - kv, d1 = d0 - 32;
            const float b0 = bt[d0 < 0 ? 0 : (d0 > 255 ? 255 : d0)], b1 = bt[d1 < 0 ? 0 : (d1 > 255 ? 255 : d1)];
            p0[r] = d0 < 0 ? NEG : p0[r] + b0; p1[r] = d1 < 0 ? NEG : p1[r] + b1;
        } else { if (kv > qpos) p0[r] = NEG; if (kv + 32 > qpos) p1[r] = NEG; } }
}

template <int DQK, bool DIFF>
__device__ __forceinline__ void attn_unit(const bf16_t* __restrict__ Qb, const bf16_t* __restrict__ Kh, const bf16_t* __restrict__ Vh, int b, int qpos0, int nrows, int NT,
                                          const float* btg, float cinit, bf16_t* Ob, float* Of, int ldo, LAS char* lds) {
    constexpr int SHM_K = KVBLK * DQK * 2, NKC = DQK / 8, KPT = NKC / 8;
    int tid_ = threadIdx.x; asm volatile("" : "+v"(tid_));
    const int tid = tid_, wid = tid >> 6, lane = tid & 63, r32 = lane & 31, hi = lane >> 5;
    LAS char* V_lds = lds + OFF_V; LAS char* K_lds = lds + OFF_K;
    LAS float* ws = (LAS float*)(lds + OFF_WS) + wid * 64; LAS float* li_l = ws; LAS float* al_l = ws + 32;
    LAS float* bt = (LAS float*)(lds + OFF_BT);
    if (DIFF) { if (tid < 256) bt[tid] = btg[tid]; }
    float m_reg = -1e30f, l_reg = 0; f32x16 o[4];
#pragma unroll
    for (int d = 0; d < 4; ++d)
#pragma unroll
        for (int r = 0; r < 16; ++r) o[d][r] = 0.f;
    bf16x8 qr[8];
    const bf16_t* Qw = Qb + (size_t)(wid * QBLK + r32) * DQK + hi * 8;
    const LAS char* qrope = lds + OFF_QR + wid * 4096;
#pragma unroll
    for (int d0 = 0; d0 < 8; ++d0) qr[d0] = *(const bf16x8*)(Qw + d0 * 16);
    if (DQK > 128) {
#pragma unroll
        for (int d0 = 8; d0 < DQK / 16; ++d0) *(LAS bf16x8*)(lds + OFF_QR + wid * 4096 + r32 * 128 + (((2 * (d0 - 8) + hi) ^ ((r32 >> 1) & 7)) << 4)) = *(const bf16x8*)(Qw + d0 * 16);
    }
    const int sr = tid >> 4, sc = (tid & 15) * 8, vst0 = v_st(sr, sc), vst1 = v_st(32 + sr, sc);
    const int vb0 = (int)(uintptr_t)V_lds + v_rd_base(lane);
    const int qposw = qpos0 + wid * QBLK, qpos = qposw + r32;
    int krow[KPT], kch[KPT], kdst[KPT];
#pragma unroll
    for (int i = 0; i < KPT; ++i) { const int idx = tid + 512 * i; krow[i] = idx / NKC; kch[i] = idx - krow[i] * NKC; kdst[i] = krow[i] * (DQK * 2) + ((kch[i] ^ kswz<DQK>(krow[i])) << 4); }
    bf16x8 vs0, vs1, ks[KPT];
#define SLOAD(k0) do { vs0 = *(const bf16x8*)(Vh + (size_t)((k0) + sr) * DV + sc); vs1 = *(const bf16x8*)(Vh + (size_t)((k0) + 32 + sr) * DV + sc); \
    _Pragma("unroll") for (int i_ = 0; i_ < KPT; ++i_) ks[i_] = *(const bf16x8*)(Kh + (size_t)((k0) + krow[i_]) * DQK + kch[i_] * 8); } while (0)
#define SWRITE(bb) do { *(LAS bf16x8*)(V_lds + (bb) * SHM_V + vst0) = vs0; *(LAS bf16x8*)(V_lds + (bb) * SHM_V + vst1) = vs1; \
    _Pragma("unroll") for (int i_ = 0; i_ < KPT; ++i_) *(LAS bf16x8*)(K_lds + (bb) * SHM_K + kdst[i_]) = ks[i_]; } while (0)
#define SWAIT() asm volatile("s_waitcnt vmcnt(0)" ::: "memory")
#define RESC(a) do { if (__any((a) < 1.f)) { if (hi == 0) al_l[r32] = (a); asm volatile("s_waitcnt lgkmcnt(0)" ::: "memory"); \
    _Pragma("unroll") for (int d = 0; d < 4; ++d) _Pragma("unroll") for (int r = 0; r < 16; ++r) o[d][r] *= al_l[crow(r, hi)]; } } while (0)
#define MASK(P0, P1, t) do { if (DIFF ? (qposw - (64 * (t) + 63) < 113) : (64 * (t) + 63 > qposw)) mask_tile<DIFF>(P0, P1, (t), qpos, hi, bt); } while (0)
    f32x16 p0, p1; float al; bf16x8 pa0, pa1, pa2, pa3;
    SLOAD(0); SWAIT(); SWRITE(0); __syncthreads();
    for (int j = 0; j < NT; ++j) {
        const int buf = j & 1;
        if (j + 1 < NT) SLOAD((j + 1) * KVBLK);
        SBAR(); qkt<DQK>(p0, p1, K_lds + buf * SHM_K, qr, qrope, r32, hi, cinit); MASK(p0, p1, j);
        partialSM(p0, p1, m_reg, al); RESC(al);
        finishSM(p0, p1, al, l_reg, pa0, pa1, pa2, pa3); SBAR();
        pv_d0(o, vb0 + buf * SHM_V, pa0, pa1, pa2, pa3);
        if (j + 1 < NT) { SWAIT(); SWRITE(buf ^ 1); }
        __syncthreads();
    }
    if (hi == 0) li_l[r32] = l_reg; asm volatile("s_waitcnt lgkmcnt(0)" ::: "memory");
#pragma unroll
    for (int r = 0; r < 16; ++r) { const int lr = wid * QBLK + crow(r, hi), pos = qpos0 + lr; const float rl = __builtin_amdgcn_rcpf(li_l[crow(r, hi)]);
        const int mrow = pos >= NMETA ? b * SEQ + pos - NMETA : MMAIN + pos;
        if (lr < nrows && (pos >= NMETA || b == 0)) {
#pragma unroll
            for (int d0 = 0; d0 < 4; ++d0) { if (DIFF) Of[(size_t)mrow * ldo + d0 * 32 + r32] = o[d0][r] * rl; else Ob[(size_t)mrow * ldo + d0 * 32 + r32] = (bf16_t)f2bf(o[d0][r] * rl); } } }
    __syncthreads();
#undef SLOAD
#undef SWRITE
#undef SWAIT
#undef RESC
#undef MASK
}
#undef SBAR
}

#define XB_TMO      128
#define XB_XCNT(j)  (256  + 64 * (j))
#define XB_XSUB(j)  (1280 + 64 * (j))
#define XB_XGEN(j)  (2304 + 64 * (j))
#define XB_TOP      3328
#define XB_TOPGEN   3392
#define XCD_BAR_WORDS 3456
#define XB_SPIN_CAP (1u << 18)
__device__ __forceinline__ unsigned xb_ld(unsigned* p)              { return __hip_atomic_load(p, __ATOMIC_RELAXED, __HIP_MEMORY_SCOPE_AGENT); }
__device__ __forceinline__ unsigned xb_add(unsigned* p, unsigned v) { return __hip_atomic_fetch_add(p, v, __ATOMIC_RELAXED, __HIP_MEMORY_SCOPE_AGENT); }
__device__ __forceinline__ unsigned xb_xcc_id() { return (unsigned)__builtin_amdgcn_s_getreg((3 << 11) | 20) & 0xFu; }
#define XB_SPIN(cond, bar) do { unsigned _sp = 0; while (cond) { __builtin_amdgcn_s_sleep(1); \
    if ((++_sp & 255u) == 0u) { if (xb_ld(&(bar)[XB_TMO])) break; if (_sp > XB_SPIN_CAP) { atomicAdd(&(bar)[XB_TMO], 1u); break; } } } } while (0)
struct XcdBarrier { unsigned* bar; unsigned x; volatile LAS unsigned* st; };
__device__ __forceinline__ XcdBarrier xcd_barrier_post(unsigned* bar, volatile LAS unsigned* st) {
    XcdBarrier b; b.bar = bar; b.x = xb_xcc_id(); b.st = st;
    if (threadIdx.x == 0) (void)xb_add(&bar[XB_XCNT(b.x)], 1u);
    return b;
}
__device__ __forceinline__ void xcd_barrier_complete(unsigned* bar, unsigned x, unsigned& nloc, unsigned& nx) {
    const unsigned G = gridDim.x * gridDim.y * gridDim.z;
    unsigned sum, cnt, mine, sp = 0u;
    for (;;) {
        sum = 0u; cnt = 0u; mine = 0u;
#pragma unroll
        for (unsigned j = 0; j < 16; ++j) { const unsigned c = xb_ld(&bar[XB_XCNT(j)]); sum += c; cnt += (c > 0u) ? 1u : 0u; mine = (j == x) ? c : mine; }
        if (sum == G) break;
        __builtin_amdgcn_s_sleep(1);
        if ((++sp & 255u) == 0u) { if (xb_ld(&bar[XB_TMO])) break; if (sp > XB_SPIN_CAP) { atomicAdd(&bar[XB_TMO], 1u); break; } }
    }
    nloc = mine > 0u ? mine : 1u; nx = cnt > 0u ? cnt : 1u;
}
__device__ __forceinline__ void xcd_barrier(const XcdBarrier& b) {
    asm volatile("s_waitcnt vmcnt(0)" ::: "memory");
    __syncthreads();
    if (threadIdx.x == 0) {
        unsigned* bar = b.bar;
        __builtin_amdgcn_s_waitcnt(0);
        unsigned nloc = b.st[0], nx = b.st[1];
        if (nloc == 0u) { xcd_barrier_complete(bar, b.x, nloc, nx); b.st[0] = nloc; b.st[1] = nx; }
        const unsigned old = xb_add(&bar[XB_XSUB(b.x)], 1u);
        const unsigned gen = old / nloc;
        if (old + 1u == (gen + 1u) * nloc) {
            __builtin_amdgcn_fence(__ATOMIC_RELEASE, "agent");
            asm volatile("s_waitcnt vmcnt(0)" ::: "memory");
            const unsigned og = xb_add(&bar[XB_TOP], 1u);
            const unsigned tg = og / nx;
            if (og + 1u == (tg + 1u) * nx) xb_add(&bar[XB_TOPGEN], 1u);
            else XB_SPIN(xb_ld(&bar[XB_TOPGEN]) == tg, bar);
            __builtin_amdgcn_fence(__ATOMIC_ACQUIRE, "agent");
            xb_add(&bar[XB_XGEN(b.x)], 1u);
            asm volatile("s_waitcnt vmcnt(0)" ::: "memory");
        } else {
            XB_SPIN(xb_ld(&bar[XB_XGEN(b.x)]) == gen, bar);
            __builtin_amdgcn_fence(__ATOMIC_ACQUIRE, "agent");
            asm volatile("s_waitcnt vmcnt(0)" ::: "memory");
        }
    }
    __syncthreads();
}

template <int MAP> __device__ __forceinline__ int wmap(int n) { return MAP == 1 ? map_win(n) : MAP == 2 ? map_wuq(n) : MAP == 3 ? map_wup(n) : n; }
template <int MAP> __device__ __forceinline__ void p0_transpose_item(const float* W, int K, int N, bf16_t* WT, LAS float* scr, int item, int lane) {
    const int nblk = N / 32, kb = item / nblk, nb = item % nblk, k0 = 64 * kb, n0 = 32 * nb;
#pragma unroll 8
    for (int i = 0; i < 32; ++i) { const int kk = 2 * i + (lane >> 5); scr[kk * 33 + (lane & 31)] = W[(size_t)(k0 + kk) * N + n0 + (lane & 31)]; }
    LDS_WAIT(); asm volatile("" ::: "memory");
    const int c = lane & 7;
#pragma unroll
    for (int j = 0; j < 4; ++j) { const int n = (lane >> 3) + 8 * j; const LAS float* s = scr + (8 * c) * 33 + n;
        u32x4 o; o.x = pk2(s[0 * 33], s[1 * 33]); o.y = pk2(s[2 * 33], s[3 * 33]); o.z = pk2(s[4 * 33], s[5 * 33]); o.w = pk2(s[6 * 33], s[7 * 33]);
        *(u32x4*)(WT + (size_t)wmap<MAP>(n0 + n) * K + k0 + 8 * c) = o; }
    LDS_WAIT(); asm volatile("" ::: "memory");
}
__device__ __forceinline__ float row_load(const float* row, int lane, f32x4 (&v)[8]) {
    float s = 0.f;
#pragma unroll
    for (int j = 0; j < 8; ++j) { v[j] = *(const f32x4*)(row + 4 * lane + 256 * j); s += (v[j][0] * v[j][0] + v[j][1] * v[j][1]) + (v[j][2] * v[j][2] + v[j][3] * v[j][3]); }
    return wave_sum(s);
}
__device__ __forceinline__ int t5_bucket(int n) {
    if (n < 16) return n;
    int lg = 16 + (int)(logf((float)n / 16.0f) / 2.0794415416798357f * 16.0f);
    return lg < 31 ? lg : 31;
}

struct SkinnyOut { bf16_t* lat; bf16_t* qd; bf16_t* kd; bf16_t* vd; float qscale; float* ao; };
template <int MODE> __device__ __forceinline__ void skinny16(LAS unsigned char* lds, const bf16_t* A, int lda, const bf16_t* Bt, int K, int nblocks, int G, int bx, const SkinnyOut& O) {
    int tid_ = threadIdx.x; asm volatile("" : "+v"(tid_));
    const int tid = tid_, lane = tid & 63, wid = __builtin_amdgcn_readfirstlane(tid >> 6), r16 = lane & 15, q4 = lane >> 4;
    LAS f32x4* part = (LAS f32x4*)lds;
    for (int blk = bx; blk < nblocks; blk += G) {
        const int brow = MODE == 0 ? (blk < 52 ? 16 * blk : 1024 + 16 * (blk - 52)) : 16 * blk;
        const int kw = K / 8; const bf16_t* ap = A + (size_t)r16 * lda + wid * kw + 8 * q4; const bf16_t* bp = Bt + (size_t)(brow + r16) * K + wid * kw + 8 * q4;
        f32x4 acc = (f32x4){0.f, 0.f, 0.f, 0.f};
#pragma unroll 8
        for (int k0 = 0; k0 < kw; k0 += 32) acc = __builtin_amdgcn_mfma_f32_16x16x32_bf16(*(const bf16x8*)(ap + k0), *(const bf16x8*)(bp + k0), acc, 0, 0, 0);
        part[wid * 64 + lane] = acc;
        __syncthreads();
        if (wid == 0) {
            f32x4 t = part[lane];
#pragma unroll
            for (int w = 1; w < 8; ++w) t += part[w * 64 + lane];
            const int wrow = brow + r16;
            if (MODE == 0) { const int qc = wrow >> 7, colin = wrow & 127;
#pragma unroll
                for (int e = 0; e < 4; ++e) { const int r = 4 * q4 + e;
                    if (qc < 8) O.lat[(size_t)(MMAIN + r) * DLAT + wrow] = (bf16_t)f2bf(t[e]);
                    else { bf16_t* base = qc < 16 ? O.qd + (size_t)(qc - 8) * LPB * 128 : qc < 24 ? O.kd + (size_t)(qc - 16) * LPB * 128 : O.vd + (size_t)(qc - 24) * LPB * 128;
                        const bf16_t v = (bf16_t)f2bf(qc < 16 ? t[e] * O.qscale : t[e]);
                        base[(size_t)r * 128 + colin] = v; base[((size_t)8 * LPB + r) * 128 + colin] = v; } }
            } else {
#pragma unroll
                for (int e = 0; e < 4; ++e) O.ao[(size_t)(MMAIN + 4 * q4 + e) * DM + wrow] = t[e];
            }
        }
        __syncthreads();
    }
}

struct Args { const float* in[22]; float* out; unsigned char* ws; int ph_lo, ph_hi; };

__global__ void __launch_bounds__(512, 2) hymba_fwd(Args args) {
    extern __shared__ __attribute__((aligned(16))) unsigned char lds_raw[];
    LAS unsigned char* lds = (LAS unsigned char*)lds_raw;
    volatile LAS unsigned* MISC = (volatile LAS unsigned*)(lds + MISC_OFF);
    const int tid = threadIdx.x, lane = tid & 63, wave = __builtin_amdgcn_readfirstlane(tid >> 6);
    const int G = gridDim.x; const int bx = blockIdx.x; const int vcu = (G % 8 == 0) ? (bx % 8) * (G / 8) + bx / 8 : bx;
    const int gw = vcu * 8 + wave, NGW = G * 8;
    unsigned char* ws = args.ws;
    unsigned* ctl = (unsigned*)(ws + WS_CTL);
    const float* x = args.in[0]; const float* meta = args.in[1]; const float* rel_bias = args.in[2];
    const float* w_in = args.in[3]; const float* w_uq = args.in[4]; const float* w_ukv = args.in[5]; const float* w_o = args.in[6];
    const float* g_attn_pre = args.in[7]; const float* g_attn_post = args.in[8]; const float* g_cq = args.in[9]; const float* g_ckv = args.in[10];
    const float* lq1 = args.in[11]; const float* lk1 = args.in[12]; const float* lq2 = args.in[13]; const float* lk2 = args.in[14];
    const float* g_sub = args.in[15]; const float* g_ffn_pre = args.in[16]; const float* g_ffn_post = args.in[17];
    const float* w_up = args.in[18]; const float* conv_w = args.in[19]; const float* conv_b = args.in[20]; const float* w_down = args.in[21];
    float* CS = (float*)(ws + WS_CS); float* BT = (float*)(ws + WS_BT);
    bf16_t* W1t = (bf16_t*)(ws + WS_W1); bf16_t* Wuqt = (bf16_t*)(ws + WS_WUQ); bf16_t* Wukvt = (bf16_t*)(ws + WS_WUKV); bf16_t* Wot = (bf16_t*)(ws + WS_WO);
    bf16_t* Wupt = (bf16_t*)(ws + WS_WUP); bf16_t* Wdnt = (bf16_t*)(ws + WS_WDN);
    bf16_t* NR = (bf16_t*)(ws + WS_NR); bf16_t* LAT = (bf16_t*)(ws + WS_LAT); bf16_t* CQN = (bf16_t*)(ws + WS_CQN); bf16_t* CKVN = (bf16_t*)(ws + WS_CKVN);
    bf16_t* QD = (bf16_t*)(ws + WS_QD); bf16_t* KD = (bf16_t*)(ws + WS_KD); bf16_t* VD = (bf16_t*)(ws + WS_VD);
    bf16_t* QM = (bf16_t*)(ws + WS_QM); bf16_t* KM = (bf16_t*)(ws + WS_KM); bf16_t* VM = (bf16_t*)(ws + WS_VM);
    bf16_t* CAT = (bf16_t*)(ws + WS_CAT); float* DP = (float*)(ws + WS_DP); float* AO = (float*)(ws + WS_AO); float* HB = (float*)(ws + WS_H);
    bf16_t* N2 = (bf16_t*)(ws + WS_N2); bf16_t* ACT = (bf16_t*)(ws + WS_ACT); float* FB = (float*)(ws + WS_F);

    for (int u = tid; u < (LDS_BYTES - LDSCTL_OFF) / 4; u += 512) ((LAS unsigned*)(lds + LDSCTL_OFF))[u] = 0u;
    __syncthreads();
#if MK_ONE_LAUNCH
    XcdBarrier bar = xcd_barrier_post(ctl + CW_BAR, MISC + 8);
#define GRID_BAR() xcd_barrier(bar)
#else
#define GRID_BAR() do {} while (0)
#endif
    const int lo = args.ph_lo, hi = args.ph_hi;
#ifndef PHASE_MASK
#define PHASE_MASK 0x7ff
#endif
#define IN(k) ((((PHASE_MASK) >> (k)) & 1) && lo <= (k) && (k) < hi)
#define SEAM(k) do { if (IN(k) && IN((k) + 1)) GRID_BAR(); } while (0)

    if (IN(0)) {
        LAS float* scr = (LAS float*)(lds + wave * 16384);
        constexpr int I_IN = (DM / 64) * (DIN / 32), I_UQ = (QL / 64) * (NQM / 32), I_UKV = (KVL / 64) * (NKV / 32), I_O = (DM / 64) * (DM / 32), I_UP = (DM / 64) * (NUP / 32), I_DN = (DFF / 64) * (DM / 32);
        constexpr int NITEMS = I_IN + I_UQ + I_UKV + I_O + I_UP + I_DN;
        for (int it = gw; it < NITEMS; it += NGW) {
            int r = it;
            if (r < I_IN) { p0_transpose_item<1>(w_in, DM, DIN, W1t, scr, r, lane); continue; } r -= I_IN;
            if (r < I_UQ) { p0_transpose_item<2>(w_uq, QL, NQM, Wuqt, scr, r, lane); continue; } r -= I_UQ;
            if (r < I_UKV) { p0_transpose_item<0>(w_ukv, KVL, NKV, Wukvt, scr, r, lane); continue; } r -= I_UKV;
            if (r < I_O) { p0_transpose_item<0>(w_o, DM, DM, Wot, scr, r, lane); continue; } r -= I_O;
            if (r < I_UP) { p0_transpose_item<3>(w_up, DM, NUP, Wupt, scr, r, lane); continue; } r -= I_UP;
            p0_transpose_item<0>(w_down, DFF, DM, Wdnt, scr, r, lane);
        }
        for (int m = gw; m < MR; m += NGW) {
            u32x2* o8 = (u32x2*)(NR + (size_t)m * DM) + lane;
            if (m >= MMAIN + NMETA) {
#pragma unroll
                for (int j = 0; j < 8; ++j) o8[64 * j] = (u32x2){0u, 0u};
                continue; }
            const float* row = m < MMAIN ? x + (size_t)m * DM : meta + (size_t)(m - MMAIN) * DM;
            f32x4 v[8]; const float ss = row_load(row, lane, v); const float rstd = rsqrtf(ss * (1.f / DM) + EPS);
#pragma unroll
            for (int j = 0; j < 8; ++j) { const f32x4 gg = *(const f32x4*)(g_attn_pre + 4 * lane + 256 * j);
                o8[64 * j] = (u32x2){pk2(v[j][0] * rstd * gg[0], v[j][1] * rstd * gg[1]), pk2(v[j][2] * rstd * gg[2], v[j][3] * rstd * gg[3])}; }
        }
        for (int it = gw; it < 4 * 16 * 48; it += NGW) { const int which = it / (16 * 48), r = it % (16 * 48), slot = r / 48, pos = LREAL + r % 48;
            bf16_t* base = which == 0 ? KD : which == 1 ? VD : which == 2 ? KM : VM; const int rb = (which == 2) ? 384 : 256;
            if (lane * 16 < rb) *(u32x4*)((char*)base + ((size_t)slot * LPB + pos) * rb + lane * 16) = (u32x4){0u, 0u, 0u, 0u}; }
        for (int e = bx * 512 + tid; e < LREAL * 32; e += G * 512) { const int pos = e >> 5, i = e & 31;
            const double inv = pow(10000.0, -(double)i / 32.0), ang = (double)pos * inv; CS[2 * e] = (float)cos(ang); CS[2 * e + 1] = (float)sin(ang); }
        for (int e = bx * 512 + tid; e < 8 * 256 + 8; e += G * 512) {
            if (e < 2048) { const int mp = e >> 8, d = e & 255; BT[e] = (rel_bias[t5_bucket(d) * 8 + mp] - rel_bias[31 * 8 + mp]) * LOG2E; }
            else BT[e] = rel_bias[31 * 8 + (e - 2048)] * LOG2E; }
    }
    SEAM(0);
    if (IN(1)) {
        { SkinnyOut so{LAT, QD, KD, VD, DIFF_QSCALE, nullptr}; skinny16<0>(lds, NR + (size_t)MMAIN * DM, DM, W1t, DM, 244, G, bx, so); }
        pg8::Gemm g{NR, W1t, DM, DM}; pg8::StaticOrder<0> S; S.init(MMAIN / 256, NP1 / 256, G, bx);
        pg8::EpiG1 E{LAT, QD, KD, VD, DIFF_QSCALE};
        pg8::gemm_phase<pg8::EpiG1, pg8::StaticOrder<0>, true>(lds, g, S, E);
    }
    SEAM(1);
    if (IN(2)) {
        for (int m = gw; m < MMAIN + NMETA; m += NGW) {
            const bf16_t* row = LAT + (size_t)m * DLAT;
            { const u32x4 w = *(const u32x4*)(row + 8 * lane); float v[8]; float s = 0.f;
#pragma unroll
              for (int k = 0; k < 4; ++k) { v[2 * k] = bf2f(w[k]); v[2 * k + 1] = bf2f(w[k] >> 16); s += v[2 * k] * v[2 * k] + v[2 * k + 1] * v[2 * k + 1]; }
              const float rstd = rsqrtf(wave_sum(s) * (1.f / QL) + EPS); const f32x4 g0 = *(const f32x4*)(g_cq + 8 * lane), g1 = *(const f32x4*)(g_cq + 8 * lane + 4);
              u32x4 o; o.x = pk2(v[0] * rstd * g0[0], v[1] * rstd * g0[1]); o.y = pk2(v[2] * rstd * g0[2], v[3] * rstd * g0[3]); o.z = pk2(v[4] * rstd * g1[0], v[5] * rstd * g1[1]); o.w = pk2(v[6] * rstd * g1[2], v[7] * rstd * g1[3]);
              *(u32x4*)(CQN + (size_t)m * QL + 8 * lane) = o; }
            { const int l4 = lane & 31; const u32x4 w = *(const u32x4*)(row + QL + 8 * l4); float v[8]; float s = 0.f;
#pragma unroll
              for (int k = 0; k < 4; ++k) { v[2 * k] = bf2f(w[k]); v[2 * k + 1] = bf2f(w[k] >> 16); s += v[2 * k] * v[2 * k] + v[2 * k + 1] * v[2 * k + 1]; }
              if (lane >= 32) s = 0.f;
              const float rstd = rsqrtf(wave_sum(s) * (1.f / KVL) + EPS); const f32x4 g0 = *(const f32x4*)(g_ckv + 8 * l4), g1 = *(const f32x4*)(g_ckv + 8 * l4 + 4);
              u32x4 o; o.x = pk2(v[0] * rstd * g0[0], v[1] * rstd * g0[1]); o.y = pk2(v[2] * rstd * g0[2], v[3] * rstd * g0[3]); o.z = pk2(v[4] * rstd * g1[0], v[5] * rstd * g1[1]); o.w = pk2(v[6] * rstd * g1[2], v[7] * rstd * g1[3]);
              if (lane < 32) *(u32x4*)(CKVN + (size_t)m * KVL + 8 * l4) = o; }
            { const int i = lane & 31; const unsigned w = *(const unsigned*)(row + 768 + 2 * i); const float x1 = bf2f(w), x2 = bf2f(w >> 16);
              int b0, pos, nb; if (m < MMAIN) { b0 = m >> 12; pos = NMETA + (m & 4095); nb = 1; } else { b0 = 0; pos = m - MMAIN; nb = 2; }
              const f32x2 csv = *(const f32x2*)(CS + ((size_t)pos * 32 + i) * 2);
              const unsigned o = pk2(x1 * csv[0] - x2 * csv[1], x2 * csv[0] + x1 * csv[1]);
              for (int k = 0; k < nb; ++k)
#pragma unroll
                  for (int hh = 0; hh < 4; ++hh) { const int h = hh + 4 * (lane >> 5); *(unsigned*)(KM + ((size_t)((b0 + k) * 8 + h) * LPB + pos) * 192 + 128 + 2 * i) = o; } }
        }
    }
    SEAM(2);
    if (IN(3)) {
#ifndef G2_SEL
#define G2_SEL 3
#endif
        if (G2_SEL & 1) { pg8::Gemm g{CQN, Wuqt, QL, QL}; pg8::StaticOrder<0> S; S.init(MR / 256, NQM / 256, G, bx);
          pg8::EpiQm E{QM, CS, MLA_QSCALE};
          pg8::gemm_phase<pg8::EpiQm, pg8::StaticOrder<0>, true>(lds, g, S, E); }
        if (G2_SEL & 2) { pg8::Gemm g{CKVN, Wukvt, KVL, KVL}; pg8::StaticOrder<0> S; S.init(MR / 256, NKV / 256, G, bx);
          pg8::EpiKv E{KM, VM};
          pg8::gemm_phase<pg8::EpiKv, pg8::StaticOrder<0>, true>(lds, g, S, E); }
    }
    SEAM(3);
    if (IN(4)) {
        LAS char* al = (LAS char*)lds; volatile LAS int* uslot = (volatile LAS int*)(al + att::OFF_U);
        for (;;) {
            if (tid == 0) uslot[0] = (int)__hip_atomic_fetch_add(ctl + CW_QUEUE, 1u, RLX_AGENT);
            __syncthreads();
            const int u = __builtin_amdgcn_readfirstlane(uslot[0]);
            __syncthreads();
            if (u >= 17 * 48) break;
            const int qb = 16 - u / 48, rem = u % 48, b = rem / 24, vh = rem % 24;
            const int qpos0 = qb == 0 ? 0 : NMETA + 256 * (qb - 1), nrows = qb == 0 ? NMETA : 256, NT = qb == 0 ? 1 : 4 * qb + 1;
#ifndef ATT_SEL
#define ATT_SEL 3
#endif
            if (vh < 8) { if (ATT_SEL & 1) { const size_t hb = (size_t)(b * 8 + vh) * LPB;
                att::attn_unit<192, false>(QM + (hb + qpos0) * 192, KM + hb * 192, VM + hb * 128, b, qpos0, nrows, NT, nullptr, 0.f, CAT + vh * 128, nullptr, DM, al); }
            } else if (ATT_SEL & 2) { const int d = vh - 8, hc = d >> 1, vhalf = d & 1, h = d >> 2; const size_t hb = (size_t)(b * 8 + hc) * LPB;
                att::attn_unit<128, true>(QD + (hb + qpos0) * 128, KD + hb * 128, VD + (size_t)(b * 8 + h * 2 + vhalf) * LPB * 128, b, qpos0, nrows, NT, BT + hc * 256, BT[2048 + hc], nullptr, DP + hc * 256 + vhalf * 128, DM, al); }
        }
    }
    SEAM(4);
    if (IN(5)) {
        float lam;
        { const float a = wave_sum(lq1[lane] * lk1[lane] + lq1[lane + 64] * lk1[lane + 64]), c = wave_sum(lq2[lane] * lk2[lane] + lq2[lane + 64] * lk2[lane + 64]); lam = expf(a) - expf(c) + LAM_INIT; }
        const f32x4 gs = *(const f32x4*)(g_sub + 4 * lane);
        for (int it = gw; it < (MMAIN + NMETA) * 4; it += NGW) { const int m = it >> 2, h = it & 3;
            const f32x4 a0 = *(const f32x4*)(DP + (size_t)m * DM + (h * 2 + 0) * 256 + 4 * lane), a1 = *(const f32x4*)(DP + (size_t)m * DM + (h * 2 + 1) * 256 + 4 * lane);
            const f32x4 dd = a0 - lam * a1; const float rstd = rsqrtf(wave_sum((dd[0] * dd[0] + dd[1] * dd[1]) + (dd[2] * dd[2] + dd[3] * dd[3])) * (1.f / 256.f) + EPS) * (1.f - LAM_INIT);
            *(u32x2*)(CAT + (size_t)m * DM + 1024 + 256 * h + 4 * lane) = (u32x2){pk2(dd[0] * rstd * gs[0], dd[1] * rstd * gs[1]), pk2(dd[2] * rstd * gs[2], dd[3] * rstd * gs[3])}; }
    }
    SEAM(5);
    if (IN(6)) {
        { SkinnyOut so{nullptr, nullptr, nullptr, nullptr, 1.f, AO}; skinny16<1>(lds, CAT + (size_t)MMAIN * DM, DM, Wot, DM, 128, G, bx, so); }
        pg8::Gemm g{CAT, Wot, DM, DM}; pg8::StaticOrder<0> S; S.init(MMAIN / 256, DM / 256, G, bx);
        pg8::EpiF32 E{AO, DM};
        pg8::gemm_phase<pg8::EpiF32, pg8::StaticOrder<0>, true>(lds, g, S, E);
    }
    SEAM(6);
    if (IN(7)) {
        for (int m = gw; m < MMAIN + NMETA; m += NGW) {
            f32x4 a[8]; const float sa = row_load(AO + (size_t)m * DM, lane, a); const float rs1 = rsqrtf(sa * (1.f / DM) + EPS);
            const float* row0 = m < MMAIN ? x + (size_t)m * DM : meta + (size_t)(m - MMAIN) * DM; float s2 = 0.f;
#pragma unroll
            for (int j = 0; j < 8; ++j) { const f32x4 gg = *(const f32x4*)(g_attn_post + 4 * lane + 256 * j), h0 = *(const f32x4*)(row0 + 4 * lane + 256 * j);
                a[j] = h0 + a[j] * rs1 * gg; s2 += (a[j][0] * a[j][0] + a[j][1] * a[j][1]) + (a[j][2] * a[j][2] + a[j][3] * a[j][3]);
                *(f32x4*)(HB + (size_t)m * DM + 4 * lane + 256 * j) = a[j]; }
            const float rs2 = rsqrtf(wave_sum(s2) * (1.f / DM) + EPS);
            int b0, pos, nb; if (m < MMAIN) { b0 = m >> 12; pos = NMETA + (m & 4095); nb = 1; } else { b0 = 0; pos = m - MMAIN; nb = 2; }
#pragma unroll
            for (int j = 0; j < 8; ++j) { const f32x4 gg = *(const f32x4*)(g_ffn_pre + 4 * lane + 256 * j);
                const u32x2 o = (u32x2){pk2(a[j][0] * rs2 * gg[0], a[j][1] * rs2 * gg[1]), pk2(a[j][2] * rs2 * gg[2], a[j][3] * rs2 * gg[3])};
                for (int k = 0; k < nb; ++k) *(u32x2*)(N2 + ((size_t)(b0 + k) * LPB + pos) * DM + 4 * lane + 256 * j) = o; }
        }
    }
    SEAM(7);
    if (IN(8)) {
        pg8::Gemm g{N2, Wupt, DM, DM}; pg8::StaticOrder<1> S; S.init(34, NUP / 256, G, bx);
        pg8::EpiConv E{ACT, conv_w, conv_b, (LAS float*)(lds + XCONV_OFF)};
        pg8::gemm_phase<pg8::EpiConv, pg8::StaticOrder<1>, true>(lds, g, S, E);
    }
    SEAM(8);
    if (IN(9)) {
        pg8::Gemm g{ACT, Wdnt, DFF, DFF}; pg8::StaticOrder<0> S; S.init(MMAIN / 256, DM / 256, G, bx);
        pg8::EpiF32 E{FB, DM};
        pg8::gemm_phase<pg8::EpiF32, pg8::StaticOrder<0>, true>(lds, g, S, E);
    }
    SEAM(9);
    if (IN(10)) {
        for (int m = gw; m < MMAIN; m += NGW) {
            f32x4 a[8]; const float sa = row_load(FB + (size_t)m * DM, lane, a); const float rs = rsqrtf(sa * (1.f / DM) + EPS);
#pragma unroll
            for (int j = 0; j < 8; ++j) { const f32x4 gg = *(const f32x4*)(g_ffn_post + 4 * lane + 256 * j), hh = *(const f32x4*)(HB + (size_t)m * DM + 4 * lane + 256 * j);
                *(f32x4*)(args.out + (size_t)m * DM + 4 * lane + 256 * j) = hh + a[j] * rs * gg; }
        }
    }
#undef IN
#undef SEAM
}

#if DEBUG_CHECK
__device__ __forceinline__ unsigned hash_u(unsigned a) { a ^= a >> 16; a *= 0x7feb352du; a ^= a >> 15; a *= 0x846ca68bu; a ^= a >> 16; return a; }
__device__ __forceinline__ float bfr(float v) { return bf2f(f2bf(v)); }
__device__ __forceinline__ void chk_rec(unsigned* chk, int stage, float got, float want, float rtol, float atol) {
    float ratio = fabsf(got - want) / (atol + rtol * fabsf(want)); if (!(ratio == ratio)) ratio = 1e30f;
    atomicMax(chk + stage, __float_as_uint(ratio));
}
struct CArgs { const float* in[22]; float* out; unsigned char* ws; };
__global__ void __launch_bounds__(64) chk_kernel(CArgs a, int stage, int nsamp) {
    const int lane = threadIdx.x; unsigned char* ws = a.ws; unsigned* chk = (unsigned*)(ws + WS_CHK);
    const float* x = a.in[0]; const float* meta = a.in[1]; const float* rel_bias = a.in[2]; const float* w_in = a.in[3]; const float* w_uq = a.in[4]; const float* w_ukv = a.in[5]; const float* w_o = a.in[6];
    const float* g_attn_pre = a.in[7]; const float* g_attn_post = a.in[8]; const float* g_cq = a.in[9]; const float* g_ckv = a.in[10];
    const float* g_sub = a.in[15]; const float* g_ffn_pre = a.in[16]; const float* w_up = a.in[18]; const float* conv_w = a.in[19]; const float* conv_b = a.in[20]; const float* w_down = a.in[21];
    const float* CS = (const float*)(ws + WS_CS);
    const bf16_t* NR = (const bf16_t*)(ws + WS_NR); const bf16_t* LAT = (const bf16_t*)(ws + WS_LAT); const bf16_t* CQN = (const bf16_t*)(ws + WS_CQN); const bf16_t* CKVN = (const bf16_t*)(ws + WS_CKVN);
    const bf16_t* QD = (const bf16_t*)(ws + WS_QD); const bf16_t* KD = (const bf16_t*)(ws + WS_KD); const bf16_t* VD = (const bf16_t*)(ws + WS_VD);
    const bf16_t* QM = (const bf16_t*)(ws + WS_QM); const bf16_t* KM = (const bf16_t*)(ws + WS_KM); const bf16_t* VM = (const bf16_t*)(ws + WS_VM);
    const bf16_t* CAT = (const bf16_t*)(ws + WS_CAT); const float* DP = (const float*)(ws + WS_DP); const float* AO = (const float*)(ws + WS_AO); const float* HB = (const float*)(ws + WS_H);
    const bf16_t* N2 = (const bf16_t*)(ws + WS_N2); const bf16_t* ACT = (const bf16_t*)(ws + WS_ACT); const float* FB = (const float*)(ws + WS_F);
    __shared__ float pbuf[LREAL + 64];
    const int s = blockIdx.x; const unsigned h0 = hash_u(s * 2654435761u + stage * 97u), h1 = hash_u(h0 + 12345u), h2 = hash_u(h1 + 777u);
    int m = (s % 8 == 0) ? MMAIN + (h0 % NMETA) : (int)(h0 % MMAIN);
    if (s % 8 == 1) m = (h0 & 1) * SEQ + (h1 % 4);
    if (s % 8 == 2) m = (h0 & 1) * SEQ + SEQ - 1 - (h1 % 4);
    int b, pos; if (m < MMAIN) { b = m >> 12; pos = NMETA + (m & 4095); } else { b = h2 & 1; pos = m - MMAIN; }
    const float* row0 = m < MMAIN ? x + (size_t)m * DM : meta + (size_t)(m - MMAIN) * DM;
    if (stage == 1) {
        float ss = 0.f; for (int k = lane; k < DM; k += 64) ss += row0[k] * row0[k]; ss = wave_sum(ss); const float rstd = rsqrtf(ss / DM + EPS);
        const int c = h1 % DM; if (lane == 0) chk_rec(chk, 1, bf2f(NR[(size_t)m * DM + c]), row0[c] * rstd * g_attn_pre[c], 1e-2f, 1e-3f);
        if (lane == 1) { const int mz = MMAIN + NMETA + (h1 % (MR - MMAIN - NMETA)); chk_rec(chk, 1, bf2f(NR[(size_t)mz * DM + c]), 0.f, 1e-2f, 1e-6f); }
    } else if (stage == 2) {
        const int n = h1 % DIN; float d = 0.f; for (int k = lane; k < DM; k += 64) d += bf2f(NR[(size_t)m * DM + k]) * bfr(w_in[(size_t)k * DIN + n]); d = wave_sum(d);
        float got;
        if (n < 832) { got = bf2f(LAT[(size_t)m * DLAT + map_win(n)]); }
        else { const int r = n - 832, typ = r >> 10, hc = (r & 1023) >> 7, col = r & 127; const bf16_t* base = typ == 0 ? QD : typ == 1 ? KD : VD; if (typ == 0) d *= DIFF_QSCALE;
            got = bf2f(base[((size_t)(b * 8 + hc) * LPB + pos) * 128 + col]); }
        if (lane == 0) chk_rec(chk, 2, got, d, 2e-2f, 2e-2f);
    } else if (stage == 3) {
        float ss = 0.f; for (int k = lane; k < QL; k += 64) { const float v = bf2f(LAT[(size_t)m * DLAT + k]); ss += v * v; } ss = wave_sum(ss);
        float s2 = 0.f; for (int k = lane; k < KVL; k += 64) { const float v = bf2f(LAT[(size_t)m * DLAT + QL + k]); s2 += v * v; } s2 = wave_sum(s2);
        const int c = h1 % QL, c2 = h1 % KVL, i = h2 % 32, hh = (h2 >> 8) % 8;
        if (lane == 0) chk_rec(chk, 3, bf2f(CQN[(size_t)m * QL + c]), bf2f(LAT[(size_t)m * DLAT + c]) * rsqrtf(ss / QL + EPS) * g_cq[c], 1e-2f, 1e-3f);
        if (lane == 1) chk_rec(chk, 3, bf2f(CKVN[(size_t)m * KVL + c2]), bf2f(LAT[(size_t)m * DLAT + QL + c2]) * rsqrtf(s2 / KVL + EPS) * g_ckv[c2], 1e-2f, 1e-3f);
        if (lane == 2) { const float x1 = bf2f(LAT[(size_t)m * DLAT + 768 + 2 * i]), x2 = bf2f(LAT[(size_t)m * DLAT + 768 + 2 * i + 1]);
            const double inv = pow(10000.0, -(double)i / 32.0), ang = pos * inv; const float cc = (float)cos(ang), sn = (float)sin(ang);
            const bf16_t* kr = KM + ((size_t)(b * 8 + hh) * LPB + pos) * 192 + 128 + 2 * i;
            chk_rec(chk, 3, bf2f(kr[0]), x1 * cc - x2 * sn, 1e-2f, 2e-3f); chk_rec(chk, 3, bf2f(kr[1]), x2 * cc + x1 * sn, 1e-2f, 2e-3f); }
    } else if (stage == 4) {
        const int h = h1 % 8;
        { const int d = h2 % 128; float q = 0.f; for (int k = lane; k < QL; k += 64) q += bf2f(CQN[(size_t)m * QL + k]) * bfr(w_uq[(size_t)k * NQM + h * 192 + d]); q = wave_sum(q);
          if (lane == 0) chk_rec(chk, 4, bf2f(QM[((size_t)(b * 8 + h) * LPB + pos) * 192 + d]), q * MLA_QSCALE, 2e-2f, 1e-2f); }
        { const int i = (h2 >> 8) % 32; float q1 = 0.f, q2 = 0.f; for (int k = lane; k < QL; k += 64) { const float c = bf2f(CQN[(size_t)m * QL + k]); q1 += c * bfr(w_uq[(size_t)k * NQM + h * 192 + 128 + i]); q2 += c * bfr(w_uq[(size_t)k * NQM + h * 192 + 160 + i]); }
          q1 = wave_sum(q1); q2 = wave_sum(q2); const double inv = pow(10000.0, -(double)i / 32.0), ang = pos * inv; const float cc = (float)cos(ang), sn = (float)sin(ang);
          const bf16_t* qp = QM + ((size_t)(b * 8 + h) * LPB + pos) * 192 + 128 + 2 * i;
          if (lane == 0) { chk_rec(chk, 4, bf2f(qp[0]), (q1 * cc - q2 * sn) * MLA_QSCALE, 2e-2f, 1e-2f); chk_rec(chk, 4, bf2f(qp[1]), (q2 * cc + q1 * sn) * MLA_QSCALE, 2e-2f, 1e-2f); } }
        { const int d = (h2 >> 16) % 256; float kv = 0.f; for (int k = lane; k < KVL; k += 64) kv += bf2f(CKVN[(size_t)m * KVL + k]) * bfr(w_ukv[(size_t)k * NKV + h * 256 + d]); kv = wave_sum(kv);
          const float got = d < 128 ? bf2f(KM[((size_t)(b * 8 + h) * LPB + pos) * 192 + d]) : bf2f(VM[((size_t)(b * 8 + h) * LPB + pos) * 128 + d - 128]);
          if (lane == 0) chk_rec(chk, 4, got, kv, 2e-2f, 2e-2f); }
    } else if (stage == 5 || stage == 6) {
        if (m >= MMAIN) b = 0;
        const bool diff = stage == 6; const int dqk = diff ? 128 : 192; const int hx = h1 % 8;
        const bf16_t* Q = diff ? QD + ((size_t)(b * 8 + hx) * LPB + pos) * 128 : QM + ((size_t)(b * 8 + hx) * LPB + pos) * 192;
        const bf16_t* K = diff ? KD + (size_t)(b * 8 + hx) * LPB * 128 : KM + (size_t)(b * 8 + hx) * LPB * 192;
        float mx = -INFINITY;
        for (int k = lane; k <= pos; k += 64) { float sc = 0.f; for (int d = 0; d < dqk; ++d) sc += bf2f(Q[d]) * bf2f(K[(size_t)k * dqk + d]);
            if (diff) { const int n = pos - k; int bk = n; if (n >= 16) { bk = 16 + (int)(logf((float)n / 16.f) / logf(8.f) * 16.f); if (bk > 31) bk = 31; } sc += rel_bias[bk * 8 + hx] * LOG2E; }
            pbuf[k] = sc; mx = fmaxf(mx, sc); }
        mx = wave_max(mx); float l = 0.f;
        for (int k = lane; k <= pos; k += 64) { const float p = exp2f(pbuf[k] - mx); pbuf[k] = p; l += p; } l = wave_sum(l); __syncthreads();
        if (!diff) { const bf16_t* V = VM + (size_t)(b * 8 + hx) * LPB * 128;
            for (int c = lane; c < 128; c += 64) { float o = 0.f; for (int k = 0; k <= pos; ++k) o += pbuf[k] * bf2f(V[(size_t)k * 128 + c]); o /= l;
                { const float got = bf2f(CAT[(size_t)m * DM + hx * 128 + c]); chk_rec(chk, m >= MMAIN ? 12 : 5, got, o, 3e-2f, 5e-3f); if (!(fabsf(got) < 1e30f)) atomicMax(chk + 14, 0x7f000000u); if (m < MMAIN) chk_rec(chk, 16, got, o, 1.5f, 0.25f); } } }
        else { const int hd = hx >> 1;
            for (int c = lane; c < 256; c += 64) { const bf16_t* V = VD + (size_t)(b * 8 + hd * 2 + (c >> 7)) * LPB * 128; float o = 0.f; for (int k = 0; k <= pos; ++k) o += pbuf[k] * bf2f(V[(size_t)k * 128 + (c & 127)]); o /= l;
                { const float got = DP[(size_t)m * DM + hx * 256 + c]; chk_rec(chk, m >= MMAIN ? 13 : 6, got, o, 3e-2f, 5e-3f); if (!(fabsf(got) < 1e30f)) atomicMax(chk + 15, 0x7f000000u); if (m < MMAIN) chk_rec(chk, 17, got, o, 1.5f, 0.25f); } } }
    } else if (stage == 7) {
        const float* lq1 = a.in[11]; const float* lk1 = a.in[12]; const float* lq2 = a.in[13]; const float* lk2 = a.in[14];
        float s1 = 0.f, s2 = 0.f; for (int k = lane; k < 128; k += 64) { s1 += lq1[k] * lk1[k]; s2 += lq2[k] * lk2[k]; } s1 = wave_sum(s1); s2 = wave_sum(s2); const float lam = expf(s1) - expf(s2) + LAM_INIT;
        const int h = h1 % 4; float ss = 0.f; for (int c = lane; c < 256; c += 64) { const float d = DP[(size_t)m * DM + (h * 2) * 256 + c] - lam * DP[(size_t)m * DM + (h * 2 + 1) * 256 + c]; ss += d * d; } ss = wave_sum(ss);
        const int c = h2 % 256; const float d = DP[(size_t)m * DM + (h * 2) * 256 + c] - lam * DP[(size_t)m * DM + (h * 2 + 1) * 256 + c];
        if (lane == 0) chk_rec(chk, 7, bf2f(CAT[(size_t)m * DM + 1024 + h * 256 + c]), d * rsqrtf(ss / 256.f + EPS) * g_sub[c] * 0.8f, 1e-2f, 1e-3f);
    } else if (stage == 8) {
        const int n = h1 % DM; float d = 0.f; for (int k = lane; k < DM; k += 64) d += bf2f(CAT[(size_t)m * DM + k]) * bfr(w_o[(size_t)k * DM + n]); d = wave_sum(d);
        if (lane == 0) chk_rec(chk, 8, AO[(size_t)m * DM + n], d, 2e-2f, 2e-2f);
    } else if (stage == 9) {
        float ss = 0.f; for (int k = lane; k < DM; k += 64) { const float v = AO[(size_t)m * DM + k]; ss += v * v; } ss = wave_sum(ss); const float rs1 = rsqrtf(ss / DM + EPS);
        float s2 = 0.f; for (int k = lane; k < DM; k += 64) { const float hv = row0[k] + AO[(size_t)m * DM + k] * rs1 * g_attn_post[k]; s2 += hv * hv; } s2 = wave_sum(s2); const float rs2 = rsqrtf(s2 / DM + EPS);
        const int c = h1 % DM; const float hv = row0[c] + AO[(size_t)m * DM + c] * rs1 * g_attn_post[c];
        if (lane == 0) { chk_rec(chk, 9, HB[(size_t)m * DM + c], hv, 1e-4f, 1e-4f); chk_rec(chk, 9, bf2f(N2[((size_t)b * LPB + pos) * DM + c]), hv * rs2 * g_ffn_pre[c], 1e-2f, 1e-3f); }
    } else if (stage == 10) {
        if (m >= MMAIN) { m = h0 % MMAIN; b = m >> 12; pos = NMETA + (m & 4095); }
        const int c = h1 % DFF; float up[2][3];
        for (int gv = 0; gv < 2; ++gv) for (int j = 0; j < 3; ++j) { const int col = gv * DFF + c; const bf16_t* nr = N2 + ((size_t)b * LPB + pos - 2 + j) * DM; float d = 0.f;
            for (int k = lane; k < DM; k += 64) d += bf2f(nr[k]) * bfr(w_up[(size_t)k * NUP + col]); up[gv][j] = wave_sum(d); }
        float cv[2]; for (int gv = 0; gv < 2; ++gv) { const int col = gv * DFF + c; cv[gv] = conv_b[col] + conv_w[col] * up[gv][0] + conv_w[NUP + col] * up[gv][1] + conv_w[2 * NUP + col] * up[gv][2]; }
        const float want = cv[0] / (1.f + expf(-cv[0])) * cv[1];
        if (lane == 0) chk_rec(chk, 10, bf2f(ACT[(size_t)m * DFF + c]), want, 3e-2f, 3e-2f);
    } else if (stage == 11) {
        if (m >= MMAIN) m = h0 % MMAIN;
        const int n = h1 % DM; float d = 0.f; for (int k = lane; k < DFF; k += 64) d += bf2f(ACT[(size_t)m * DFF + k]) * bfr(w_down[(size_t)k * DM + n]); d = wave_sum(d);
        if (lane == 0) chk_rec(chk, 11, FB[(size_t)m * DM + n], d, 2e-2f, 2e-2f);
    }
}
__global__ void __launch_bounds__(64) naive_attn(CArgs a) {
    const int lane = threadIdx.x; unsigned char* ws = a.ws; const float* rel_bias = a.in[2];
    const bf16_t* QD = (const bf16_t*)(ws + WS_QD); const bf16_t* KD = (const bf16_t*)(ws + WS_KD); const bf16_t* VD = (const bf16_t*)(ws + WS_VD);
    const bf16_t* QM = (const bf16_t*)(ws + WS_QM); const bf16_t* KM = (const bf16_t*)(ws + WS_KM); const bf16_t* VM = (const bf16_t*)(ws + WS_VM);
    bf16_t* CAT = (bf16_t*)(ws + WS_CAT); float* DP = (float*)(ws + WS_DP);
    __shared__ float pbuf[LREAL + 64];
    const int m = blockIdx.x / 16, task = blockIdx.x % 16; const bool diff = task >= 8; const int hx = task & 7, dqk = diff ? 128 : 192;
    int b, pos; if (m < MMAIN) { b = m >> 12; pos = NMETA + (m & 4095); } else { b = 0; pos = m - MMAIN; }
    const bf16_t* Q = diff ? QD + ((size_t)(b * 8 + hx) * LPB + pos) * 128 : QM + ((size_t)(b * 8 + hx) * LPB + pos) * 192;
    const bf16_t* K = diff ? KD + (size_t)(b * 8 + hx) * LPB * 128 : KM + (size_t)(b * 8 + hx) * LPB * 192;
    float mx = -INFINITY;
    for (int k = lane; k <= pos; k += 64) { float sc = 0.f; for (int d = 0; d < dqk; ++d) sc += bf2f(Q[d]) * bf2f(K[(size_t)k * dqk + d]);
        if (diff) { const int n = pos - k; int bk = n; if (n >= 16) { bk = 16 + (int)(logf((float)n / 16.f) / logf(8.f) * 16.f); if (bk > 31) bk = 31; } sc += rel_bias[bk * 8 + hx] * LOG2E; }
        pbuf[k] = sc; mx = fmaxf(mx, sc); }
    mx = wave_max(mx); float l = 0.f;
    for (int k = lane; k <= pos; k += 64) { const float p = exp2f(pbuf[k] - mx); pbuf[k] = p; l += p; } l = wave_sum(l); __syncthreads();
    if (!diff) { const bf16_t* V = VM + (size_t)(b * 8 + hx) * LPB * 128;
        for (int c = lane; c < 128; c += 64) { float o = 0.f; for (int k = 0; k <= pos; ++k) o += pbuf[k] * bf2f(V[(size_t)k * 128 + c]); CAT[(size_t)m * DM + hx * 128 + c] = (bf16_t)f2bf(o / l); } }
    else { const int hd = hx >> 1;
        for (int c = lane; c < 256; c += 64) { const bf16_t* V = VD + (size_t)(b * 8 + hd * 2 + (c >> 7)) * LPB * 128; float o = 0.f; for (int k = 0; k <= pos; ++k) o += pbuf[k] * bf2f(V[(size_t)k * 128 + (c & 127)]); DP[(size_t)m * DM + hx * 256 + c] = o / l; } }
}
__global__ void __launch_bounds__(256) chk_poison(float* out, int n, const unsigned* chk) {
    int first = 0, mask = 0;
    for (int k = 1; k <= 13; ++k) if (k != 5 && k != 6 && __uint_as_float(chk[k]) > 1.f && first == 0) first = k;
    const int ids[6] = {5, 6, 14, 15, 16, 17};
    for (int i = 0; i < 6; ++i) if (__uint_as_float(chk[ids[i]]) > 1.f) mask |= 1 << i;
    if (first == 0 && mask == 0) return;
    const float c = sqrtf(3.f * exp2f((float)first));
    for (int i = blockIdx.x * 256 + threadIdx.x; i < n; i += gridDim.x * 256) { if (i == 12345) { if (mask) out[i] = 100.f + 10.f * mask; } else if (first) out[i] = c; }
}
#endif

extern "C" void kernel_launch(void* const* d_in, const int* in_sizes, int n_in, void* d_out, int out_size, void* d_ws, size_t ws_size, hipStream_t stream) {
    static int grid = 0;
    if (grid == 0) {
        if (n_in != 22 || in_sizes[0] != MMAIN * DM || out_size != MMAIN * DM || ws_size < WS_END) {
            fprintf(stderr, "kernel_launch: unexpected shapes: n_in %d in0 %d out %d ws %zu (need %zu)\n", n_in, n_in > 0 ? in_sizes[0] : -1, out_size, ws_size, (size_t)WS_END); grid = -1; return; }
        int dev = 0, cus = 0;
        if (hipGetDevice(&dev) != hipSuccess || hipDeviceGetAttribute(&cus, hipDeviceAttributeMultiprocessorCount, dev) != hipSuccess) { grid = -1; return; }
        if (hipFuncSetAttribute((const void*)hymba_fwd, hipFuncAttributeMaxDynamicSharedMemorySize, LDS_BYTES) != hipSuccess) { fprintf(stderr, "kernel_launch: hipFuncSetAttribute failed\n"); grid = -1; return; }
        int per_cu = 0; (void)hipOccupancyMaxActiveBlocksPerMultiprocessor(&per_cu, (const void*)hymba_fwd, 512, LDS_BYTES); (void)hipGetLastError();
        grid = cus;
    }
    if (grid < 0) return;
    (void)hipMemsetAsync((char*)d_ws + WS_CTL, 0, CTL_ZERO_BYTES, stream);
    Args a{};
    for (int i = 0; i < 22; ++i) a.in[i] = (const float*)d_in[i];
    a.out = (float*)d_out; a.ws = (unsigned char*)d_ws;
#if !DEBUG_CHECK
#if MK_ONE_LAUNCH
    a.ph_lo = 0; a.ph_hi = 11;
    hipLaunchKernelGGL(hymba_fwd, dim3(grid), dim3(512), LDS_BYTES, stream, a);
#else
    for (int p = 0; p < 11; ++p) { a.ph_lo = p; a.ph_hi = p + 1; hipLaunchKernelGGL(hymba_fwd, dim3(grid), dim3(512), LDS_BYTES, stream, a); }
#endif
#else
    CArgs c{}; for (int i = 0; i < 22; ++i) c.in[i] = (const float*)d_in[i]; c.out = (float*)d_out; c.ws = (unsigned char*)d_ws;
    static const int stage_after_phase[12] = {0, 0, 1, 2, 3, 4, 4, 5, 6, 7, 8, 9};
    int done = -1;
    for (int k = 1; k <= 11; ++k) {
        for (int p = done + 1; p <= stage_after_phase[k]; ++p) { a.ph_lo = p; a.ph_hi = p + 1; hipLaunchKernelGGL(hymba_fwd, dim3(grid), dim3(512), LDS_BYTES, stream, a); }
        if (stage_after_phase[k] > done) done = stage_after_phase[k];
        hipLaunchKernelGGL(chk_kernel, dim3(k == 5 || k == 6 ? 192 : 768), dim3(64), 0, stream, c, k, 0);
        if (k == 6) hipLaunchKernelGGL(naive_attn, dim3((MMAIN + NMETA) * 16), dim3(64), 0, stream, c);
    }
    a.ph_lo = 10; a.ph_hi = 11; hipLaunchKernelGGL(hymba_fwd, dim3(grid), dim3(512), LDS_BYTES, stream, a);
    hipLaunchKernelGGL(chk_poison, dim3(1024), dim3(256), 0, stream, (float*)d_out, out_size, (const unsigned*)((char*)d_ws + WS_CHK));
#endif
    const hipError_t le = hipPeekAtLastError();
    if (le != hipSuccess) fprintf(stderr, "kernel_launch: launch failed: %s\n", hipGetErrorName(le));
}
```

```cpp
#include <hip/hip_runtime.h>
#include <hip/hip_bf16.h>
#include <cstdio>
#include <cstdint>
#include <cmath>

#ifndef MK_ONE_LAUNCH
#define MK_ONE_LAUNCH 1
#endif
#ifndef DEBUG_CHECK
#define DEBUG_CHECK 0
#endif

#define LAS __attribute__((address_space(3)))
#define GAS __attribute__((address_space(1)))
typedef unsigned short bf16_t;
typedef short bf16x8 __attribute__((ext_vector_type(8)));
typedef short s16x4 __attribute__((ext_vector_type(4)));
typedef float f32x4 __attribute__((ext_vector_type(4)));
typedef float f32x2 __attribute__((ext_vector_type(2)));
typedef float f32x16 __attribute__((ext_vector_type(16)));
typedef unsigned u32x4 __attribute__((ext_vector_type(4)));
typedef unsigned u32x2 __attribute__((ext_vector_type(2)));

constexpr int DM = 2048, SEQ = 4096, NMETA = 16, LREAL = SEQ + NMETA  , LPB = 4352  ;
constexpr int MMAIN = 2 * SEQ  , MR = 8448  ;
constexpr int DIN = 3904, NP1 = 4096, DLAT = 1024;
constexpr int QL = 512, KVL = 256, NQM = 1536, NKV = 2048;
constexpr int DFF = 5632, NUP = 2 * DFF;
constexpr float EPS = 1e-6f;
constexpr float LOG2E = 1.4426950408889634f;
constexpr float MLA_QSCALE = 0.07216878364870322f * LOG2E;
constexpr float DIFF_QSCALE = 0.08838834764831845f * LOG2E;
constexpr float LAM_INIT = 0.2f;

constexpr size_t MiB = 1u << 20;
constexpr size_t WS_CTL = 0, CTL_ZERO_BYTES = 1 * MiB;
constexpr size_t WS_CS = 1 * MiB;
constexpr size_t WS_BT = 3 * MiB;
constexpr size_t WS_W1 = 4 * MiB;
constexpr size_t WS_WUQ = 20 * MiB;
constexpr size_t WS_WUKV = 22 * MiB;
constexpr size_t WS_WO = 23 * MiB;
constexpr size_t WS_WUP = 31 * MiB;
constexpr size_t WS_WDN = 75 * MiB;
constexpr size_t WS_A = 97 * MiB;
constexpr size_t WS_NR = WS_A + 0 * MiB;
constexpr size_t WS_LAT = WS_A + 33 * MiB;
constexpr size_t WS_CQN = WS_A + 50 * MiB;
constexpr size_t WS_CKVN = WS_A + 59 * MiB;
constexpr size_t WS_QD = WS_A + 64 * MiB;
constexpr size_t WS_KD = WS_A + 81 * MiB;
constexpr size_t WS_VD = WS_A + 98 * MiB;
constexpr size_t WS_QM = WS_A + 115 * MiB;
constexpr size_t WS_KM = WS_A + 141 * MiB;
constexpr size_t WS_VM = WS_A + 167 * MiB;
constexpr size_t WS_CAT = WS_A + 0 * MiB;
constexpr size_t WS_DP = WS_A + 184 * MiB;
constexpr size_t WS_AO = WS_A + 33 * MiB;
constexpr size_t WS_H = WS_A + 99 * MiB;
constexpr size_t WS_N2 = WS_A + 165 * MiB;
constexpr size_t WS_ACT = WS_A + 0 * MiB;
constexpr size_t WS_F = WS_A + 165 * MiB;
constexpr size_t WS_END = WS_A + 250 * MiB;
constexpr size_t WS_CHK = 512 * 1024;
constexpr int CW_BAR = 4096;
constexpr int CW_QUEUE = 16384;

constexpr int RING_BYTES = 131072, LDSCTL_OFF = 139264, MISC_OFF = LDSCTL_OFF + 320, XCONV_OFF = 141312, LDS_BYTES = 151552;

#define RLX_AGENT __ATOMIC_RELAXED, __HIP_MEMORY_SCOPE_AGENT
#define LDS_WAIT() asm volatile("s_waitcnt lgkmcnt(0)" ::: "memory")
#define VM_WAIT() asm volatile("s_waitcnt vmcnt(0)" ::: "memory")
__host__ __device__ __forceinline__ unsigned f2bf(float f) { unsigned u = __builtin_bit_cast(unsigned, f); return (u + 0x7fffu + ((u >> 16) & 1u)) >> 16; }
__host__ __device__ __forceinline__ float bf2f(unsigned h) { return __builtin_bit_cast(float, (h & 0xffffu) << 16); }
__device__ __forceinline__ unsigned pk2(float lo, float hi) { return f2bf(lo) | (f2bf(hi) << 16); }
__device__ __forceinline__ unsigned cvt_pk_bf16(float lo, float hi) { unsigned r; asm volatile("v_cvt_pk_bf16_f32 %0, %1, %2" : "=v"(r) : "v"(lo), "v"(hi)); return r; }
__device__ __forceinline__ int lane_id() { int l; asm volatile("v_mbcnt_lo_u32_b32 %0, -1, 0\n\tv_mbcnt_hi_u32_b32 %0, -1, %0" : "=v"(l)); return l; }
__device__ __forceinline__ float wave_sum(float v) {
#pragma unroll
    for (int o = 1; o < 64; o <<= 1) v += __shfl_xor(v, o);
    return v;
}
__device__ __forceinline__ float wave_max(float v) {
#pragma unroll
    for (int o = 1; o < 64; o <<= 1) v = fmaxf(v, __shfl_xor(v, o));
    return v;
}
__device__ __forceinline__ int row_dests(int pm, int lr, int& b0, int& pos) {
    if (pm < 32) { b0 = pm >> 4; pos = NMETA + (pm & 15) * 256 + lr; return 1; }
    b0 = 0; pos = lr; return (pm == 32 && lr < NMETA) ? 2 : 0;
}
__host__ __device__ __forceinline__ int map_win(int n) { if (n < 768) return n; if (n < 832) { const int i = n - 768; return 768 + 2 * (i & 31) + (i >> 5); } return n + 192; }
__host__ __device__ __forceinline__ int map_wuq(int n) { const int h = n / 192, d = n - 192 * h; if (d < 128) return n; const int i = d - 128; return h * 192 + 128 + 2 * (i & 31) + (i >> 5); }
__host__ __device__ __forceinline__ int map_wup(int n) { if (n < DFF) return (n >> 7) * 256 + (n & 127); const int m = n - DFF; return (m >> 7) * 256 + 128 + (m & 127); }

namespace pg8 {
constexpr int BM = 256, BK = 64, HALF = 128, HTB = HALF * BK * 2, STAGE_BYTES = 8 * HTB, NXCD = 8, WGM = 8;
__host__ __device__ __forceinline__ int lds_byte(int r, int c) { const int st = (r >> 4) * 2 + (c >> 5), rr = r & 15, cc = c & 31, ob = rr * 64 + cc * 2; return st * 1024 + (ob ^ (((ob >> 9) & 1) << 5)); }
__host__ __device__ __forceinline__ void stage_rc(int b, int& R, int& C) { const int st = b / 1024, sb = b % 1024, swz = sb ^ (((sb >> 9) & 1) << 5); R = (st >> 1) * 16 + swz / 64; C = (st & 1) * 32 + (swz % 64) / 2; }
__host__ __device__ __forceinline__ int perm32(int rho) { const int n = rho >> 4, i = rho & 15; return 8 * (i >> 2) + 4 * n + (i & 3); }

struct Unit { int pm, pn, arow; };
struct Gemm { const bf16_t* A; const bf16_t* Bt; int lda; int K; };

template <int MODE> struct StaticOrder {
    int nM, nN, nwg, G, c;
    __device__ void init(int nM_, int nN_, int G_, int c_) { nM = nM_; nN = nN_; nwg = nM * nN; G = G_; c = c_; }
    __device__ bool next(int i, Unit& u) const {
        const long L = (long)i * G + c; if (L >= nwg) return false;
        int wgid = (int)L; { const int q = nwg / NXCD, r = nwg % NXCD, xcd = wgid % NXCD, off = wgid / NXCD; wgid = (xcd < r ? xcd * (q + 1) : r * (q + 1) + (xcd - r) * q) + off; }
        const int nig = WGM * nN, gid = wgid / nig, fm = gid * WGM, gsz = (nM - fm) < WGM ? (nM - fm) : WGM;
        u.pm = fm + ((wgid % nig) % gsz); u.pn = (wgid % nig) / gsz;
        if (MODE == 0) u.arow = u.pm * BM; else { const int b = u.pm / 17, i2 = u.pm - 17 * b; u.arow = b * LPB + 14 + 254 * i2; }
        return true;
    }
};

__device__ __forceinline__ u32x4 pack8(const f32x4 v0, const f32x4 v1) { u32x4 w; w.x = cvt_pk_bf16(v0[0], v0[1]); w.y = cvt_pk_bf16(v0[2], v0[3]); w.z = cvt_pk_bf16(v1[0], v1[1]); w.w = cvt_pk_bf16(v1[2], v1[3]); return w; }

struct EpiG1 {
    static constexpr bool PERM = true;
    bf16_t* lat; bf16_t* qd; bf16_t* kd; bf16_t* vd; float qscale;
    __device__ __forceinline__ void operator()(f32x4 (&acc)[2][2][4][2], const Unit& u, int wr, int wc, int fr_in, int fq) const {
        int fr = fr_in; asm volatile("" : "+v"(fr));
        const int colin = wc * 32 + 8 * fq;
#pragma unroll
        for (int bj = 0; bj < 2; ++bj) {
            const int q = 2 * u.pn + bj; float sc = 1.f; bf16_t* base;
            if (q < 8) base = lat + 128 * q + colin;
            else if (q < 16) { base = qd + (size_t)(q - 8) * LPB * 128 + colin; sc = qscale; }
            else if (q < 24) base = kd + (size_t)(q - 16) * LPB * 128 + colin;
            else base = vd + (size_t)(q - 24) * LPB * 128 + colin;
#pragma unroll
            for (int ai = 0; ai < 2; ++ai)
#pragma unroll
                for (int m = 0; m < 4; ++m) {
                    const int lr = ai * HALF + wr * 64 + m * 16 + fr;
                    const u32x4 w = pack8(acc[ai][bj][m][0] * sc, acc[ai][bj][m][1] * sc);
                    if (q < 8) { *(u32x4*)(base + (size_t)(u.pm * BM + lr) * DLAT) = w; }
                    else { int b0, pos; const int nb = row_dests(u.pm, lr, b0, pos);
                        for (int k = 0; k < nb; ++k) *(u32x4*)(base + ((size_t)(b0 + k) * 8 * LPB + pos) * 128) = w; }
                }
        }
    }
};
struct EpiQm {
    static constexpr bool PERM = true;
    bf16_t* qm; const float* cs; float qscale;
    __device__ __forceinline__ void operator()(f32x4 (&acc)[2][2][4][2], const Unit& u, int wr, int wc, int fr_in, int fq) const {
        int fr = fr_in; asm volatile("" : "+v"(fr));
#pragma unroll
        for (int bj = 0; bj < 2; ++bj) {
            const int c0 = u.pn * BM + bj * HALF + wc * 32 + 8 * fq, h = c0 / 192, d = c0 - 192 * h; const bool rope = d >= 128; const int i0 = (d - 128) >> 1;
#pragma unroll
            for (int ai = 0; ai < 2; ++ai)
#pragma unroll
                for (int m = 0; m < 4; ++m) {
                    const int lr = ai * HALF + wr * 64 + m * 16 + fr; int b0, pos; const int nb = row_dests(u.pm, lr, b0, pos);
                    f32x4 v0 = acc[ai][bj][m][0], v1 = acc[ai][bj][m][1];
                    if (rope && nb) { const f32x4 t0 = *(const f32x4*)(cs + ((size_t)pos * 32 + i0) * 2), t1 = *(const f32x4*)(cs + ((size_t)pos * 32 + i0 + 2) * 2);
                        const f32x4 a0 = v0, a1 = v1;
                        v0[0] = a0[0] * t0[0] - a0[1] * t0[1]; v0[1] = a0[1] * t0[0] + a0[0] * t0[1]; v0[2] = a0[2] * t0[2] - a0[3] * t0[3]; v0[3] = a0[3] * t0[2] + a0[2] * t0[3];
                        v1[0] = a1[0] * t1[0] - a1[1] * t1[1]; v1[1] = a1[1] * t1[0] + a1[0] * t1[1]; v1[2] = a1[2] * t1[2] - a1[3] * t1[3]; v1[3] = a1[3] * t1[2] + a1[2] * t1[3]; }
                    const u32x4 w = pack8(v0 * qscale, v1 * qscale);
                    for (int k = 0; k < nb; ++k) *(u32x4*)(qm + ((size_t)((b0 + k) * 8 + h) * LPB + pos) * 192 + d) = w;
                    asm volatile("" ::: "memory");
                }
        }
    }
};
struct EpiKv {
    static constexpr bool PERM = true;
    bf16_t* km; bf16_t* vm;
    __device__ __forceinline__ void operator()(f32x4 (&acc)[2][2][4][2], const Unit& u, int wr, int wc, int fr_in, int fq) const {
        int fr = fr_in; asm volatile("" : "+v"(fr));
        const int colin = wc * 32 + 8 * fq, h = u.pn;
#pragma unroll
        for (int ai = 0; ai < 2; ++ai)
#pragma unroll
            for (int m = 0; m < 4; ++m) {
                const int lr = ai * HALF + wr * 64 + m * 16 + fr; int b0, pos; const int nb = row_dests(u.pm, lr, b0, pos);
                const u32x4 w0 = pack8(acc[ai][0][m][0], acc[ai][0][m][1]), w1 = pack8(acc[ai][1][m][0], acc[ai][1][m][1]);
                for (int k = 0; k < nb; ++k) { const unsigned row = (unsigned)((b0 + k) * 8 + h) * LPB + pos;
                    *(u32x4*)(km + (size_t)row * 192 + colin) = w0; *(u32x4*)(vm + (size_t)row * 128 + colin) = w1; }
                asm volatile("" ::: "memory");
            }
    }
};
struct EpiB16 {
    static constexpr bool PERM = true;
    bf16_t* out; int ldc;
    __device__ __forceinline__ void operator()(f32x4 (&acc)[2][2][4][2], const Unit& u, int wr, int wc, int fr_in, int fq) const {
        int fr = fr_in; asm volatile("" : "+v"(fr));
        const int col0 = u.pn * BM + wc * 32 + 8 * fq;
#pragma unroll
        for (int ai = 0; ai < 2; ++ai)
#pragma unroll
            for (int m = 0; m < 4; ++m) { bf16_t* rowp = out + (size_t)(u.pm * BM + ai * HALF + wr * 64 + m * 16 + fr) * ldc + col0;
#pragma unroll
                for (int bj = 0; bj < 2; ++bj) *(u32x4*)(rowp + bj * HALF) = pack8(acc[ai][bj][m][0], acc[ai][bj][m][1]); }
    }
};
struct EpiF32 {
    static constexpr bool PERM = false;
    float* out; int ldc;
    __device__ __forceinline__ void operator()(f32x4 (&acc)[2][2][4][2], const Unit& u, int wr, int wc, int fr_in, int fq) const {
        int fr = fr_in; asm volatile("" : "+v"(fr));
        const int col0 = u.pn * BM + wc * 32 + 4 * fq;
#pragma unroll
        for (int ai = 0; ai < 2; ++ai)
#pragma unroll
            for (int m = 0; m < 4; ++m) { float* rowp = out + (size_t)(u.pm * BM + ai * HALF + wr * 64 + m * 16 + fr) * ldc + col0;
#pragma unroll
                for (int bj = 0; bj < 2; ++bj)
#pragma unroll
                    for (int n = 0; n < 2; ++n) *(f32x4*)(rowp + bj * HALF + n * 16) = acc[ai][bj][m][n]; }
    }
};
__device__ __forceinline__ float ror1(float v) { return __builtin_bit_cast(float, __builtin_amdgcn_update_dpp(0, __builtin_bit_cast(int, v), 0x121, 0xf, 0xf, false)); }
__device__ __forceinline__ float ror2(float v) { return __builtin_bit_cast(float, __builtin_amdgcn_update_dpp(0, __builtin_bit_cast(int, v), 0x122, 0xf, 0xf, false)); }
struct EpiConv {
    static constexpr bool PERM = true;
    bf16_t* act; const float* cw; const float* cb; LAS float* X;
    __device__ __forceinline__ void operator()(f32x4 (&acc)[2][2][4][2], const Unit& u, int wr, int wc, int fr_in, int fq) const {
        int fr = fr_in; asm volatile("" : "+v"(fr));
        const int colx = wc * 32 + 8 * fq;
        if (fr >= 14) {
#pragma unroll
            for (int ai = 0; ai < 2; ++ai)
#pragma unroll
                for (int bj = 0; bj < 2; ++bj)
#pragma unroll
                    for (int n = 0; n < 2; ++n) *(LAS f32x4*)(X + (((2 * ai + wr) * 2 + (fr - 14)) * 256 + bj * HALF + colx + 4 * n)) = acc[ai][bj][3][n];
        }
        asm volatile("s_waitcnt lgkmcnt(0)" ::: "memory"); __builtin_amdgcn_s_barrier(); asm volatile("" ::: "memory");
#pragma unroll
        for (int bj = 0; bj < 2; ++bj)
#pragma unroll
            for (int n = 0; n < 2; ++n) {
                const int gcol = (bj ? DFF : 0) + u.pn * HALF + colx + 4 * n;
                const f32x4 w0 = *(const f32x4*)(cw + gcol), w1 = *(const f32x4*)(cw + NUP + gcol), w2 = *(const f32x4*)(cw + 2 * NUP + gcol), bb = *(const f32x4*)(cb + gcol);
#pragma unroll
                for (int ai = 0; ai < 2; ++ai) {
                    const int g = 2 * ai + wr;
                    f32x4 x62 = (f32x4){0.f, 0.f, 0.f, 0.f}, x63 = x62;
                    if (g > 0) { x62 = *(const LAS f32x4*)(X + (((g - 1) * 2 + 0) * 256 + bj * HALF + colx + 4 * n)); x63 = *(const LAS f32x4*)(X + (((g - 1) * 2 + 1) * 256 + bj * HALF + colx + 4 * n)); }
                    f32x4 s1, s2;
#pragma unroll
                    for (int e = 0; e < 4; ++e) { s1[e] = ror1(acc[ai][bj][3][n][e]); s2[e] = ror2(acc[ai][bj][3][n][e]); }
#pragma unroll
                    for (int m = 3; m >= 0; --m) {
                        f32x4 q1, q2;
                        if (m > 0) {
#pragma unroll
                            for (int e = 0; e < 4; ++e) { q1[e] = ror1(acc[ai][bj][m - 1][n][e]); q2[e] = ror2(acc[ai][bj][m - 1][n][e]); }
                        } else { q1 = x63; q2 = (fr == 0) ? x62 : x63; }
                        const f32x4 cur = acc[ai][bj][m][n]; f32x4 nw;
#pragma unroll
                        for (int e = 0; e < 4; ++e) { const float p1 = (fr == 0) ? q1[e] : s1[e], p2 = (fr < 2) ? q2[e] : s2[e]; nw[e] = bb[e] + w0[e] * p2 + w1[e] * p1 + w2[e] * cur[e]; }
                        asm volatile("" : "+v"(nw[0]), "+v"(nw[1]), "+v"(nw[2]), "+v"(nw[3]));
                        acc[ai][bj][m][n] = nw; s1 = q1; s2 = q2;
                    }
                    asm volatile("" ::: "memory");
                }
                __builtin_amdgcn_sched_barrier(0);
            }
        const int b = u.pm / 17, i2 = u.pm - 17 * b, p0 = 14 + 254 * i2;
#pragma unroll
        for (int ai = 0; ai < 2; ++ai)
#pragma unroll
            for (int m = 0; m < 4; ++m) {
                const int lr = ai * HALF + wr * 64 + m * 16 + fr, pos = p0 + lr;
                f32x4 o0, o1;
#pragma unroll
                for (int e = 0; e < 4; ++e) { const float g0 = acc[ai][0][m][0][e], g1 = acc[ai][0][m][1][e];
                    o0[e] = g0 * __builtin_amdgcn_rcpf(1.f + __builtin_amdgcn_exp2f(-g0 * LOG2E)) * acc[ai][1][m][0][e];
                    o1[e] = g1 * __builtin_amdgcn_rcpf(1.f + __builtin_amdgcn_exp2f(-g1 * LOG2E)) * acc[ai][1][m][1][e]; }
                if (lr >= 2 && pos < LREAL) *(u32x4*)(act + (size_t)(b * SEQ + pos - NMETA) * DFF + u.pn * HALF + colx) = pack8(o0, o1);
                asm volatile("" ::: "memory");
            }
    }
};

template <class Epi, class Sched, bool ALIGN_EPI>
__device__ __forceinline__ void gemm_phase(LAS unsigned char* lds, const Gemm g, const Sched& S, const Epi& E, int wave_s) {
    int tid_ = wave_s * 64 + lane_id(); asm volatile("" : "+v"(tid_));
    const int tid = tid_, wid = __builtin_amdgcn_readfirstlane(tid >> 6), lane = tid & 63, wr = wid >> 2, wc = wid & 3, fr = lane & 15, fq = lane >> 4;
    const int K = g.K, nt = K / BK, lda = g.lda;
    unsigned voffA[2], voffB[2];
#pragma unroll
    for (int i = 0; i < 2; ++i) { int R, C; stage_rc(tid * 16 + i * 8192, R, C); const int Rb = Epi::PERM ? ((R & ~31) + perm32(R & 31)) : R;
        voffA[i] = (unsigned)(R * lda + C) * 2u; voffB[i] = (unsigned)(Rb * K + C) * 2u; }
    const size_t kstep = (size_t)(BK * 2);
    const size_t hstepA = (size_t)HALF * lda * 2, hstepB = (size_t)HALF * K * 2;
    const size_t tstepB = 2 * hstepB;
    const unsigned ldsw = (unsigned)wid * 1024u;
    const int aoff = lds_byte(wr * 64 + fr, fq * 8), boff = lds_byte(wc * 32 + fr, fq * 8);
#define PG8_SA(b, h) (((b) * 2 + (h)) * HTB)
#define PG8_SB(b, h) ((4 + (b) * 2 + (h)) * HTB)
#define PG8_STAGE(bufoff, gbase, voff) do { _Pragma("unroll") for (int _i = 0; _i < 2; ++_i) \
        __builtin_amdgcn_global_load_lds((const unsigned*)((const char*)(gbase) + (voff)[_i]), (LAS unsigned*)(lds + (bufoff) + ldsw + _i * 8192), 16, 0, 0); } while (0)
#define PG8_LDA(dst, b, h) do { _Pragma("unroll") for (int m = 0; m < 4; ++m) _Pragma("unroll") for (int k = 0; k < 2; ++k) dst[m][k] = *(const LAS bf16x8*)(lds + PG8_SA(b, h) + aoff + m * 2048 + k * 1024); } while (0)
#define PG8_LDB(dst, b, h) do { _Pragma("unroll") for (int n = 0; n < 2; ++n) _Pragma("unroll") for (int k = 0; k < 2; ++k) dst[n][k] = *(const LAS bf16x8*)(lds + PG8_SB(b, h) + boff + n * 2048 + k * 1024); } while (0)
#define PG8_MMA(ai, bj, At, Bt) do { __builtin_amdgcn_s_setprio(1); _Pragma("unroll") for (int m = 0; m < 4; ++m) _Pragma("unroll") for (int n = 0; n < 2; ++n) _Pragma("unroll") for (int k = 0; k < 2; ++k) \
        acc[ai][bj][m][n] = __builtin_amdgcn_mfma_f32_16x16x32_bf16(Bt[n][k], At[m][k], acc[ai][bj][m][n], 0, 0, 0); __builtin_amdgcn_s_setprio(0); } while (0)
#define PG8_WAIT_V(n) asm volatile("s_waitcnt vmcnt(" #n ")" ::: "memory")
#define PG8_WAIT_L(n) asm volatile("s_waitcnt lgkmcnt(" #n ")" ::: "memory")
#define PG8_BAR __builtin_amdgcn_s_barrier()
#define PG8_SCHED __builtin_amdgcn_sched_barrier(0)
    Unit cur, nxt; int ui = 0;
    if (!S.next(0, cur)) return;
    f32x4 acc[2][2][4][2];
#pragma unroll
    for (int a = 0; a < 2; ++a)
#pragma unroll
        for (int b = 0; b < 2; ++b)
#pragma unroll
            for (int m = 0; m < 4; ++m)
#pragma unroll
                for (int n = 0; n < 2; ++n) acc[a][b][m][n] = (f32x4){0.f, 0.f, 0.f, 0.f};
    bf16x8 At[4][2], B0[2][2], B1[2][2];
    const char* cA = (const char*)g.A + (size_t)cur.arow * lda * 2; const char* cB = (const char*)g.Bt + (size_t)cur.pn * tstepB;
    PG8_STAGE(PG8_SB(0, 0), cB, voffB); PG8_STAGE(PG8_SB(0, 1), cB + hstepB, voffB); PG8_STAGE(PG8_SA(0, 0), cA, voffA); PG8_STAGE(PG8_SA(0, 1), cA + hstepA, voffA);
    if (wr == 1) PG8_BAR;
    PG8_WAIT_V(2); PG8_BAR;
    PG8_STAGE(PG8_SB(1, 0), cB + kstep, voffB); PG8_STAGE(PG8_SA(1, 0), cA + kstep, voffA); PG8_STAGE(PG8_SB(1, 1), cB + hstepB + kstep, voffB);
    PG8_WAIT_V(6); PG8_BAR;
    for (;;) {
        const bool has_next = S.next(ui + 1, nxt);
        const char* nA = has_next ? (const char*)g.A + (size_t)nxt.arow * lda * 2 : cA; const char* nB = has_next ? (const char*)g.Bt + (size_t)nxt.pn * tstepB : cB;
        for (int t = 0; t < nt; t += 2) {
            const bool last = (t == nt - 2);
            const char* a1 = cA + (size_t)(t + 1) * kstep;
            const char* a2 = last ? nA : cA + (size_t)(t + 2) * kstep; const char* b2 = last ? nB : cB + (size_t)(t + 2) * kstep;
            const char* a3 = a2 + kstep; const char* b3 = b2 + kstep;
            PG8_LDB(B0, 0, 0); PG8_LDB(B1, 0, 1); PG8_SCHED; PG8_LDA(At, 0, 0); PG8_STAGE(PG8_SA(1, 1), a1 + hstepA, voffA);
            PG8_WAIT_V(8); PG8_WAIT_L(0); PG8_BAR; PG8_MMA(0, 0, At, B0); PG8_MMA(0, 1, At, B1); PG8_BAR; PG8_SCHED;
            PG8_LDA(At, 0, 1); PG8_STAGE(PG8_SB(0, 0), b2, voffB); PG8_STAGE(PG8_SB(0, 1), b2 + hstepB, voffB); PG8_STAGE(PG8_SA(0, 0), a2, voffA);
            PG8_WAIT_V(8); PG8_WAIT_L(0); PG8_BAR; PG8_MMA(1, 0, At, B0); PG8_MMA(1, 1, At, B1); PG8_BAR; PG8_SCHED;
            PG8_LDB(B0, 1, 0); PG8_LDB(B1, 1, 1); PG8_SCHED; PG8_LDA(At, 1, 0); PG8_STAGE(PG8_SA(0, 1), a2 + hstepA, voffA);
            PG8_WAIT_V(8); PG8_WAIT_L(0); PG8_BAR; PG8_MMA(0, 0, At, B0); PG8_MMA(0, 1, At, B1); PG8_BAR; PG8_SCHED;
            PG8_LDA(At, 1, 1); PG8_STAGE(PG8_SB(1, 0), b3, voffB); PG8_STAGE(PG8_SB(1, 1), b3 + hstepB, voffB); PG8_STAGE(PG8_SA(1, 0), a3, voffA);
            PG8_WAIT_V(8); PG8_WAIT_L(0); PG8_BAR; PG8_MMA(1, 0, At, B0); PG8_MMA(1, 1, At, B1); PG8_BAR; PG8_SCHED;
        }
        if constexpr (ALIGN_EPI) { if (wr == 0) PG8_BAR; }
        E(acc, cur, wr, wc, fr, fq);
        if (!has_next) break;
#pragma unroll
        for (int a = 0; a < 2; ++a)
#pragma unroll
            for (int b = 0; b < 2; ++b)
#pragma unroll
                for (int m = 0; m < 4; ++m)
#pragma unroll
                    for (int n = 0; n < 2; ++n) acc[a][b][m][n] = (f32x4){0.f, 0.f, 0.f, 0.f};
        cur = nxt; cA = nA; cB = nB; ++ui;
        if constexpr (ALIGN_EPI) { if (wr == 1) PG8_BAR; }
    }
    PG8_WAIT_V(0);
    if constexpr (!ALIGN_EPI) { if (wr == 0) PG8_BAR; }
    PG8_BAR;
#undef PG8_SA
#undef PG8_SB
#undef PG8_STAGE
#undef PG8_LDA
#undef PG8_LDB
#undef PG8_MMA
#undef PG8_WAIT_V
#undef PG8_WAIT_L
#undef PG8_BAR
#undef PG8_SCHED
}
}

namespace att {
constexpr int NW = 8, QBLK = 32, KVBLK = 64, DV = 128;
constexpr int SHM_V = KVBLK * DV * 2;
constexpr int OFF_V = 0  , OFF_K = 3 * SHM_V  , OFF_WS = OFF_K + 2 * KVBLK * 192 * 2  , OFF_BT = OFF_WS + NW * 64 * 4, OFF_U = OFF_BT + 2048, OFF_QR = OFF_U + 1024, ATT_LDS = OFF_QR + NW * 4096  ;
static_assert(ATT_LDS <= LDSCTL_OFF, "attention LDS map");
constexpr float THR = 8.f;
#define SBAR() __builtin_amdgcn_sched_barrier(0)
__device__ __forceinline__ int crow(int r, int hi) { return (r & 3) + 8 * (r >> 2) + 4 * hi; }
template <int DQK> __device__ __forceinline__ int kswz(int row) { return DQK == 128 ? (row & 15) : ((row >> 1) & 7); }

__device__ __forceinline__ void partialSM(f32x16& p0, f32x16& p1, float& m_reg, float& alpha) {
    float pmax = p0[0];
#pragma unroll
    for (int r = 1; r < 16; ++r) pmax = fmaxf(pmax, p0[r]);
#pragma unroll
    for (int r = 0; r < 16; ++r) pmax = fmaxf(pmax, p1[r]);
    { auto rr = __builtin_amdgcn_permlane32_swap(__float_as_uint(pmax), __float_as_uint(pmax), false, false);
      pmax = fmaxf(__uint_as_float(rr[0]), __uint_as_float(rr[1])); }
    float mn;
    if (__builtin_expect(__all(pmax - m_reg <= THR), 1)) { mn = m_reg; alpha = 1.f; }
    else { mn = fmaxf(m_reg, pmax); alpha = __builtin_amdgcn_exp2f(m_reg - mn); m_reg = mn; }
#pragma unroll
    for (int r = 0; r < 16; ++r) p0[r] = p0[r] - mn;
#pragma unroll
    for (int r = 0; r < 16; ++r) p1[r] = p1[r] - mn;
#pragma unroll
    for (int r = 0; r < 16; ++r) p0[r] = __builtin_amdgcn_exp2f(p0[r]);
}
__device__ __forceinline__ void finishSM(f32x16& p0, f32x16& p1, float alpha, float& l_reg, bf16x8& pa0, bf16x8& pa1, bf16x8& pa2, bf16x8& pa3) {
#pragma unroll
    for (int r = 0; r < 16; ++r) p1[r] = __builtin_amdgcn_exp2f(p1[r]);
    float ps = 0;
#pragma unroll
    for (int r = 0; r < 16; ++r) ps += p0[r];
#pragma unroll
    for (int r = 0; r < 16; ++r) ps += p1[r];
    { auto rr = __builtin_amdgcn_permlane32_swap(__float_as_uint(ps), __float_as_uint(ps), false, false);
      ps = __uint_as_float(rr[0]) + __uint_as_float(rr[1]); }
    l_reg = l_reg * alpha + ps;
#define PK4(P, BASE, OUT) do { unsigned a0 = cvt_pk_bf16(P[BASE + 0], P[BASE + 1]), a1 = cvt_pk_bf16(P[BASE + 2], P[BASE + 3]);   \
    unsigned b0 = cvt_pk_bf16(P[BASE + 4], P[BASE + 5]), b1 = cvt_pk_bf16(P[BASE + 6], P[BASE + 7]);                              \
    auto r0 = __builtin_amdgcn_permlane32_swap(a0, b0, false, false); auto r1 = __builtin_amdgcn_permlane32_swap(a1, b1, false, false); \
    u32x4 w = {r0[0], r1[0], r0[1], r1[1]}; OUT = __builtin_bit_cast(bf16x8, w); } while (0)
    PK4(p0, 0, pa0); PK4(p0, 8, pa1); PK4(p1, 0, pa2); PK4(p1, 8, pa3);
#undef PK4
}
template <int DQK> __device__ __forceinline__ void qkt(f32x16& p0, f32x16& p1, const LAS char* Ks, const bf16x8* qr, const LAS char* qrope, int r32, int hi, float cinit) {
#pragma unroll
    for (int r = 0; r < 16; ++r) { p0[r] = cinit; p1[r] = cinit; }
    const int sw = kswz<DQK>(r32);
    __builtin_amdgcn_s_setprio(1);
    const LAS char* k0 = Ks + r32 * (DQK * 2); const LAS char* k1 = Ks + (32 + r32) * (DQK * 2);
#pragma unroll
    for (int d0 = 0; d0 < DQK / 16; ++d0) { const int off = ((2 * d0 + hi) ^ sw) << 4;
        const bf16x8 b0 = *(const LAS bf16x8*)(k0 + off), b1 = *(const LAS bf16x8*)(k1 + off);
        constexpr int NQR = DQK / 16 - 4;
        bf16x8 qv; if (d0 < NQR) qv = qr[d0 < NQR ? d0 : 0]; else qv = *(const LAS bf16x8*)(qrope + r32 * 128 + (((2 * (d0 - NQR) + hi) ^ ((r32 >> 1) & 7)) << 4));
        p0 = __builtin_amdgcn_mfma_f32_32x32x16_bf16(b0, qv, p0, 0, 0, 0);
        p1 = __builtin_amdgcn_mfma_f32_32x32x16_bf16(b1, qv, p1, 0, 0, 0);
        if ((d0 & 3) == 3) SBAR(); }
    __builtin_amdgcn_s_setprio(0);
}
__device__ __forceinline__ int v_st(int k, int c) { const int kk = (k & ~0xC) | ((k & 4) << 1) | ((k & 8) >> 1); return ((kk >> 3) * 4 + (c >> 5)) * 512 + ((kk & 7) * 32 + (c & 31)) * 2; }
__device__ __forceinline__ int v_rd_base(int lane) { return ((lane & 3) << 3) | (((lane >> 2) & 3) << 6) | (((lane >> 4) & 1) << 5) | (((lane >> 5) & 1) << 8); }
constexpr int v_rd_off(int d0, int ks, int half) { return d0 * 512 + ks * 4096 + half * 2048; }
template <int OFF> __device__ __forceinline__ s16x4 tr_read(int vb) { s16x4 r; asm volatile("ds_read_b64_tr_b16 %0, %1 offset:%2" : "=&v"(r) : "v"(vb), "i"(OFF) : "memory"); return r; }
template <int D0> __device__ __forceinline__ void pv_one(f32x16& od, int vb, bf16x8 pa0, bf16x8 pa1, bf16x8 pa2, bf16x8 pa3) {
    const s16x4 l0 = tr_read<v_rd_off(D0, 0, 0)>(vb), h0 = tr_read<v_rd_off(D0, 0, 1)>(vb), l1 = tr_read<v_rd_off(D0, 1, 0)>(vb), h1 = tr_read<v_rd_off(D0, 1, 1)>(vb);
    const s16x4 l2 = tr_read<v_rd_off(D0, 2, 0)>(vb), h2 = tr_read<v_rd_off(D0, 2, 1)>(vb), l3 = tr_read<v_rd_off(D0, 3, 0)>(vb), h3 = tr_read<v_rd_off(D0, 3, 1)>(vb);
    asm volatile("s_waitcnt lgkmcnt(0)" ::: "memory"); SBAR();
#define PK(L, H) (bf16x8){L[0], L[1], L[2], L[3], H[0], H[1], H[2], H[3]}
    od = __builtin_amdgcn_mfma_f32_32x32x16_bf16(pa0, PK(l0, h0), od, 0, 0, 0);
    od = __builtin_amdgcn_mfma_f32_32x32x16_bf16(pa1, PK(l1, h1), od, 0, 0, 0);
    od = __builtin_amdgcn_mfma_f32_32x32x16_bf16(pa2, PK(l2, h2), od, 0, 0, 0);
    od = __builtin_amdgcn_mfma_f32_32x32x16_bf16(pa3, PK(l3, h3), od, 0, 0, 0);
#undef PK
}
__device__ __forceinline__ void pv_d0(f32x16* o, int vb, bf16x8 pa0, bf16x8 pa1, bf16x8 pa2, bf16x8 pa3) {
    pv_one<0>(o[0], vb, pa0, pa1, pa2, pa3); pv_one<1>(o[1], vb, pa0, pa1, pa2, pa3); pv_one<2>(o[2], vb, pa0, pa1, pa2, pa3); pv_one<3>(o[3], vb, pa0, pa1, pa2, pa3);
}
template <bool DIFF> __device__ __forceinline__ void mask_tile(f32x16& p0, f32x16& p1, int t, int qpos, int hi, const LAS float* bt) {
    const float NEG = -INFINITY; const int kb = 64 * t + 4 * hi, dq = qpos - kb;
    const LAS float* tb = bt + (256 - dq);
#pragma unroll
    for (int r = 0; r < 16; ++r) { const int cr = (r & 3) + 8 * (r >> 2);
        if (DIFF) { p0[r] = cr > dq ? NEG : p0[r] + tb[cr]; p1[r] = cr + 32 > dq ? NEG : p1[r] + tb[cr + 32]; if ((r & 1) == 1) SBAR(); }
        else { if (cr > dq) p0[r] = NEG; if (cr + 32 > dq) p1[r] = NEG; } }
}

template <int DQK, bool DIFF>
__device__ __forceinline__ void attn_unit(const bf16_t* __restrict__ Qb, const bf16_t* __restrict__ Kh, const bf16_t* __restrict__ Vh, int b, int qpos0, int nrows, int NT,
                                          const float* btg, float cinit, bf16_t* Ob, int ldo, LAS char* lds, int wave_s) {
    constexpr int SHM_K = KVBLK * DQK * 2, NKC = DQK / 8, KPT = NKC / 8;
    int tid_ = wave_s * 64 + lane_id(); asm volatile("" : "+v"(tid_));
    const int tid = tid_, wid = tid >> 6, lane = tid & 63, r32 = lane & 31, hi = lane >> 5;
    LAS char* V_lds = lds + OFF_V; LAS char* K_lds = lds + OFF_K;
    LAS float* ws = (LAS float*)(lds + OFF_WS) + wid * 64; LAS float* li_l = ws; LAS float* al_l = ws + 32;
    LAS float* bt = (LAS float*)(lds + OFF_BT);
    if (DIFF) bt[tid] = btg[tid];
    float m_reg = -1e30f, l_reg = 0; f32x16 o[4];
#pragma unroll
    for (int d = 0; d < 4; ++d)
#pragma unroll
        for (int r = 0; r < 16; ++r) o[d][r] = 0.f;
    constexpr int NQR = DQK / 16 - 4;
    bf16x8 qr[NQR];
    const bf16_t* Qw = Qb + (size_t)(wid * QBLK + r32) * DQK + hi * 8;
    const LAS char* qrope = lds + OFF_QR + wid * 4096;
#pragma unroll
    for (int d0 = 0; d0 < NQR; ++d0) qr[d0] = *(const bf16x8*)(Qw + d0 * 16);
#pragma unroll
    for (int d0 = NQR; d0 < DQK / 16; ++d0) *(LAS bf16x8*)(lds + OFF_QR + wid * 4096 + r32 * 128 + (((2 * (d0 - NQR) + hi) ^ ((r32 >> 1) & 7)) << 4)) = *(const bf16x8*)(Qw + d0 * 16);
    const int wu = __builtin_amdgcn_readfirstlane(tid >> 6);
    const int vb0 = (int)(uintptr_t)V_lds + v_rd_base(lane);
    const int qposw = qpos0 + wid * QBLK, qpos = qposw + r32;
#define DMA_TILE(t) do { int l_ = lane; asm volatile("" : "+v"(l_)); \
    const char* kt_ = (const char*)(Kh + (size_t)(t) * KVBLK * DQK); const char* vt_ = (const char*)(Vh + (size_t)(t) * KVBLK * DV); \
    LAS char* kd_ = K_lds + ((t) & 1) * SHM_K + wu * (KPT * 1024); LAS char* vd_ = V_lds + ((t) & 1) * SHM_V + wu * 2048; \
    _Pragma("unroll") for (int i_ = 0; i_ < KPT; ++i_) { const int p_ = (wu * KPT + i_) * 64 + l_, kr_ = p_ / NKC, kc_ = (p_ - kr_ * NKC) ^ kswz<DQK>(kr_); \
        __builtin_amdgcn_global_load_lds((const unsigned*)(kt_ + (unsigned)(kr_ * DQK + kc_ * 8) * 2u), (LAS unsigned*)(kd_ + i_ * 1024), 16, 0, 0); } \
    _Pragma("unroll") for (int i_ = 0; i_ < 2; ++i_) { const int p_ = (wu * 2 + i_) * 64 + l_, sb_ = p_ >> 5, kk_ = (sb_ >> 2) * 8 + ((p_ >> 2) & 7), k_ = (kk_ & ~0xC) | ((kk_ & 4) << 1) | ((kk_ & 8) >> 1), c_ = (sb_ & 3) * 32 + (p_ & 3) * 8; \
        __builtin_amdgcn_global_load_lds((const unsigned*)(vt_ + (unsigned)(k_ * DV + c_) * 2u), (LAS unsigned*)(vd_ + i_ * 1024), 16, 0, 0); } } while (0)
#define TILE_BAR() do { asm volatile("s_waitcnt vmcnt(0)" ::: "memory"); __syncthreads(); } while (0)
#define RESC(a) do { if (__any((a) < 1.f)) { if (hi == 0) al_l[r32] = (a); asm volatile("s_waitcnt lgkmcnt(0)" ::: "memory"); \
    _Pragma("unroll") for (int d = 0; d < 4; ++d) _Pragma("unroll") for (int r = 0; r < 16; ++r) o[d][r] *= al_l[crow(r, hi)]; } } while (0)
#define MASK(P0, P1, t) do { if (DIFF ? (qposw - (64 * (t) + 63) < 113) : (64 * (t) + 63 > qposw)) mask_tile<DIFF>(P0, P1, (t), qpos, hi, bt); } while (0)
    f32x16 p0, p1; float al; bf16x8 pa0, pa1, pa2, pa3;
    DMA_TILE(0);
    TILE_BAR();
    for (int j = 0; j < NT; ++j) {
        const int buf = j & 1;
        if (j + 1 < NT) DMA_TILE(j + 1);
        SBAR(); qkt<DQK>(p0, p1, K_lds + buf * SHM_K, qr, qrope, r32, hi, cinit); MASK(p0, p1, j);
        partialSM(p0, p1, m_reg, al); RESC(al);
        finishSM(p0, p1, al, l_reg, pa0, pa1, pa2, pa3); SBAR();
        pv_d0(o, vb0 + buf * SHM_V, pa0, pa1, pa2, pa3);
        TILE_BAR();
    }
    if (hi == 0) li_l[r32] = l_reg; asm volatile("s_waitcnt lgkmcnt(0)" ::: "memory");
#pragma unroll
    for (int r = 0; r < 16; ++r) { const int lr = wid * QBLK + crow(r, hi), pos = qpos0 + lr; const float rl = __builtin_amdgcn_rcpf(li_l[crow(r, hi)]);
        const int mrow = pos >= NMETA ? b * SEQ + pos - NMETA : MMAIN + pos;
        if (lr < nrows && (pos >= NMETA || b == 0)) {
#pragma unroll
            for (int d0 = 0; d0 < 4; ++d0) Ob[(size_t)mrow * ldo + d0 * 32 + r32] = (bf16_t)f2bf(o[d0][r] * rl); } }
    __syncthreads();
#undef DMA_TILE
#undef TILE_BAR
#undef RESC
#undef MASK
}
#undef SBAR
}

#define XB_TMO      128
#define XB_XCNT(j)  (256  + 64 * (j))
#define XB_XSUB(j)  (1280 + 64 * (j))
#define XB_XGEN(j)  (2304 + 64 * (j))
#define XB_TOP      3328
#define XB_TOPGEN   3392
#define XCD_BAR_WORDS 3456
#define XB_SPIN_CAP (1u << 18)
__device__ __forceinline__ unsigned xb_ld(unsigned* p)              { return __hip_atomic_load(p, __ATOMIC_RELAXED, __HIP_MEMORY_SCOPE_AGENT); }
__device__ __forceinline__ unsigned xb_add(unsigned* p, unsigned v) { return __hip_atomic_fetch_add(p, v, __ATOMIC_RELAXED, __HIP_MEMORY_SCOPE_AGENT); }
__device__ __forceinline__ unsigned xb_xcc_id() { return (unsigned)__builtin_amdgcn_s_getreg((3 << 11) | 20) & 0xFu; }
#define XB_SPIN(cond, bar) do { unsigned _sp = 0; while (cond) { __builtin_amdgcn_s_sleep(1); \
    if ((++_sp & 255u) == 0u) { if (xb_ld(&(bar)[XB_TMO])) break; if (_sp > XB_SPIN_CAP) { atomicAdd(&(bar)[XB_TMO], 1u); break; } } } } while (0)
struct XcdBarrier { unsigned* bar; unsigned x; volatile LAS unsigned* st; int w; };
__device__ __forceinline__ XcdBarrier xcd_barrier_post(unsigned* bar, volatile LAS unsigned* st, int w) {
    XcdBarrier b; b.bar = bar; b.x = xb_xcc_id(); b.st = st; b.w = w;
    if (w == 0 && lane_id() == 0) (void)xb_add(&bar[XB_XCNT(b.x)], 1u);
    return b;
}
__device__ __forceinline__ void xcd_barrier_complete(unsigned* bar, unsigned x, unsigned& nloc, unsigned& nx) {
    const unsigned G = gridDim.x * gridDim.y * gridDim.z;
    unsigned sum, cnt, mine, sp = 0u;
    for (;;) {
        sum = 0u; cnt = 0u; mine = 0u;
#pragma unroll
        for (unsigned j = 0; j < 16; ++j) { const unsigned c = xb_ld(&bar[XB_XCNT(j)]); sum += c; cnt += (c > 0u) ? 1u : 0u; mine = (j == x) ? c : mine; }
        if (sum == G) break;
        __builtin_amdgcn_s_sleep(1);
        if ((++sp & 255u) == 0u) { if (xb_ld(&bar[XB_TMO])) break; if (sp > XB_SPIN_CAP) { atomicAdd(&bar[XB_TMO], 1u); break; } }
    }
    nloc = mine > 0u ? mine : 1u; nx = cnt > 0u ? cnt : 1u;
}
__device__ __forceinline__ void xcd_barrier(const XcdBarrier& b) {
    asm volatile("s_waitcnt vmcnt(0)" ::: "memory");
    __syncthreads();
    if (b.w == 0 && lane_id() == 0) {
        unsigned* bar = b.bar;
        __builtin_amdgcn_s_waitcnt(0);
        unsigned nloc = b.st[0], nx = b.st[1];
        if (nloc == 0u) { xcd_barrier_complete(bar, b.x, nloc, nx); b.st[0] = nloc; b.st[1] = nx; }
        const unsigned old = xb_add(&bar[XB_XSUB(b.x)], 1u);
        const unsigned gen = old / nloc;
        if (old + 1u == (gen + 1u) * nloc) {
            __builtin_amdgcn_fence(__ATOMIC_RELEASE, "agent");
            asm volatile("s_waitcnt vmcnt(0)" ::: "memory");
            const unsigned og = xb_add(&bar[XB_TOP], 1u);
            const unsigned tg = og / nx;
            if (og + 1u == (tg + 1u) * nx) xb_add(&bar[XB_TOPGEN], 1u);
            else XB_SPIN(xb_ld(&bar[XB_TOPGEN]) == tg, bar);
            __builtin_amdgcn_fence(__ATOMIC_ACQUIRE, "agent");
            xb_add(&bar[XB_XGEN(b.x)], 1u);
            asm volatile("s_waitcnt vmcnt(0)" ::: "memory");
        } else {
            XB_SPIN(xb_ld(&bar[XB_XGEN(b.x)]) == gen, bar);
            __builtin_amdgcn_fence(__ATOMIC_ACQUIRE, "agent");
            asm volatile("s_waitcnt vmcnt(0)" ::: "memory");
        }
    }
    __syncthreads();
}

template <int MAP> __device__ __forceinline__ int wmap(int n) { return MAP == 1 ? map_win(n) : MAP == 2 ? map_wuq(n) : MAP == 3 ? map_wup(n) : n; }
template <int MAP> __device__ __forceinline__ void p0_transpose_item(const float* W, int K, int N, bf16_t* WT, LAS float* scr, int item, int lane) {
    const int nblk = N / 32, kb = item / nblk, nb = item % nblk, k0 = 64 * kb, n0 = 32 * nb;
#pragma unroll 8
    for (int i = 0; i < 32; ++i) { const int kk = 2 * i + (lane >> 5); scr[kk * 33 + (lane & 31)] = W[(size_t)(k0 + kk) * N + n0 + (lane & 31)]; }
    LDS_WAIT(); asm volatile("" ::: "memory");
    const int c = lane & 7;
#pragma unroll
    for (int j = 0; j < 4; ++j) { const int n = (lane >> 3) + 8 * j; const LAS float* s = scr + (8 * c) * 33 + n;
        u32x4 o; o.x = pk2(s[0 * 33], s[1 * 33]); o.y = pk2(s[2 * 33], s[3 * 33]); o.z = pk2(s[4 * 33], s[5 * 33]); o.w = pk2(s[6 * 33], s[7 * 33]);
        *(u32x4*)(WT + (size_t)wmap<MAP>(n0 + n) * K + k0 + 8 * c) = o; }
    LDS_WAIT(); asm volatile("" ::: "memory");
}
__device__ __forceinline__ float row_load(const float* row, int lane, f32x4 (&v)[8]) {
    float s = 0.f;
#pragma unroll
    for (int j = 0; j < 8; ++j) { v[j] = *(const f32x4*)(row + 4 * lane + 256 * j); s += (v[j][0] * v[j][0] + v[j][1] * v[j][1]) + (v[j][2] * v[j][2] + v[j][3] * v[j][3]); }
    return wave_sum(s);
}
__device__ __forceinline__ float row_load_bf16(const bf16_t* row, int lane, f32x4 (&v)[8]) {
    float s = 0.f;
#pragma unroll
    for (int j = 0; j < 8; ++j) { const u32x2 w = *(const u32x2*)(row + 4 * lane + 256 * j); v[j] = (f32x4){bf2f(w[0]), bf2f(w[0] >> 16), bf2f(w[1]), bf2f(w[1] >> 16)};
        s += (v[j][0] * v[j][0] + v[j][1] * v[j][1]) + (v[j][2] * v[j][2] + v[j][3] * v[j][3]); }
    return wave_sum(s);
}
__device__ __forceinline__ int t5_bucket(int n) {
    if (n < 16) return n;
    int lg = 16 + (int)(logf((float)n / 16.0f) / 2.0794415416798357f * 16.0f);
    return lg < 31 ? lg : 31;
}

struct SkinnyOut { bf16_t* lat; bf16_t* qd; bf16_t* kd; bf16_t* vd; float qscale; bf16_t* ao; };
template <int MODE> __device__ __forceinline__ void skinny16(LAS unsigned char* lds, const bf16_t* A, int lda, const bf16_t* Bt, int K, int nblocks, int G, int bx, const SkinnyOut& O, int wave_s) {
    int tid_ = wave_s * 64 + lane_id(); asm volatile("" : "+v"(tid_));
    const int tid = tid_, lane = tid & 63, wid = __builtin_amdgcn_readfirstlane(tid >> 6), r16 = lane & 15, q4 = lane >> 4;
    LAS f32x4* part = (LAS f32x4*)lds;
    for (int blk = bx; blk < nblocks; blk += G) {
        const int brow = MODE == 0 ? (blk < 52 ? 16 * blk : 1024 + 16 * (blk - 52)) : 16 * blk;
        const int kw = K / 8; const bf16_t* ap = A + (size_t)r16 * lda + wid * kw + 8 * q4; const bf16_t* bp = Bt + (size_t)(brow + r16) * K + wid * kw + 8 * q4;
        f32x4 acc = (f32x4){0.f, 0.f, 0.f, 0.f};
#pragma unroll 8
        for (int k0 = 0; k0 < kw; k0 += 32) acc = __builtin_amdgcn_mfma_f32_16x16x32_bf16(*(const bf16x8*)(ap + k0), *(const bf16x8*)(bp + k0), acc, 0, 0, 0);
        part[wid * 64 + lane] = acc;
        __syncthreads();
        if (wid == 0) {
            f32x4 t = part[lane];
#pragma unroll
            for (int w = 1; w < 8; ++w) t += part[w * 64 + lane];
            const int wrow = brow + r16;
            if (MODE == 0) { const int qc = wrow >> 7, colin = wrow & 127;
#pragma unroll
                for (int e = 0; e < 4; ++e) { const int r = 4 * q4 + e;
                    if (qc < 8) O.lat[(size_t)(MMAIN + r) * DLAT + wrow] = (bf16_t)f2bf(t[e]);
                    else { bf16_t* base = qc < 16 ? O.qd + (size_t)(qc - 8) * LPB * 128 : qc < 24 ? O.kd + (size_t)(qc - 16) * LPB * 128 : O.vd + (size_t)(qc - 24) * LPB * 128;
                        const bf16_t v = (bf16_t)f2bf(qc < 16 ? t[e] * O.qscale : t[e]);
                        base[(size_t)r * 128 + colin] = v; base[((size_t)8 * LPB + r) * 128 + colin] = v; } }
            } else {
#pragma unroll
                for (int e = 0; e < 4; ++e) O.ao[(size_t)(MMAIN + 4 * q4 + e) * DM + wrow] = (bf16_t)f2bf(t[e]);
            }
        }
        __syncthreads();
    }
}

struct Args { const float* in[22]; float* out; unsigned char* ws; int ph_lo, ph_hi; };

__global__ void __launch_bounds__(512, 2) hymba_fwd(Args args) {
    extern __shared__ __attribute__((aligned(16))) unsigned char lds_raw[];
    LAS unsigned char* lds = (LAS unsigned char*)lds_raw;
    volatile LAS unsigned* MISC = (volatile LAS unsigned*)(lds + MISC_OFF);
    const int wave = __builtin_amdgcn_readfirstlane(threadIdx.x >> 6);
#define tid (wave * 64 + lane_id())
#define lane lane_id()
    const int G = gridDim.x; const int bx = blockIdx.x; const int vcu = (G % 8 == 0) ? (bx % 8) * (G / 8) + bx / 8 : bx;
    const int gw = vcu * 8 + wave, NGW = G * 8;
    unsigned char* ws = args.ws;
    unsigned* ctl = (unsigned*)(ws + WS_CTL);
    const float* x = args.in[0]; const float* meta = args.in[1]; const float* rel_bias = args.in[2];
    const float* w_in = args.in[3]; const float* w_uq = args.in[4]; const float* w_ukv = args.in[5]; const float* w_o = args.in[6];
    const float* g_attn_pre = args.in[7]; const float* g_attn_post = args.in[8]; const float* g_cq = args.in[9]; const float* g_ckv = args.in[10];
    const float* lq1 = args.in[11]; const float* lk1 = args.in[12]; const float* lq2 = args.in[13]; const float* lk2 = args.in[14];
    const float* g_sub = args.in[15]; const float* g_ffn_pre = args.in[16]; const float* g_ffn_post = args.in[17];
    const float* w_up = args.in[18]; const float* conv_w = args.in[19]; const float* conv_b = args.in[20]; const float* w_down = args.in[21];
    float* CS = (float*)(ws + WS_CS); float* BT = (float*)(ws + WS_BT);
    bf16_t* W1t = (bf16_t*)(ws + WS_W1); bf16_t* Wuqt = (bf16_t*)(ws + WS_WUQ); bf16_t* Wukvt = (bf16_t*)(ws + WS_WUKV); bf16_t* Wot = (bf16_t*)(ws + WS_WO);
    bf16_t* Wupt = (bf16_t*)(ws + WS_WUP); bf16_t* Wdnt = (bf16_t*)(ws + WS_WDN);
    bf16_t* NR = (bf16_t*)(ws + WS_NR); bf16_t* LAT = (bf16_t*)(ws + WS_LAT); bf16_t* CQN = (bf16_t*)(ws + WS_CQN); bf16_t* CKVN = (bf16_t*)(ws + WS_CKVN);
    bf16_t* QD = (bf16_t*)(ws + WS_QD); bf16_t* KD = (bf16_t*)(ws + WS_KD); bf16_t* VD = (bf16_t*)(ws + WS_VD);
    bf16_t* QM = (bf16_t*)(ws + WS_QM); bf16_t* KM = (bf16_t*)(ws + WS_KM); bf16_t* VM = (bf16_t*)(ws + WS_VM);
    bf16_t* CAT = (bf16_t*)(ws + WS_CAT); bf16_t* DP = (bf16_t*)(ws + WS_DP); bf16_t* AO = (bf16_t*)(ws + WS_AO); float* HB = (float*)(ws + WS_H);
    bf16_t* N2 = (bf16_t*)(ws + WS_N2); bf16_t* ACT = (bf16_t*)(ws + WS_ACT); bf16_t* FB = (bf16_t*)(ws + WS_F);

    for (int u = tid; u < (LDS_BYTES - LDSCTL_OFF) / 4; u += 512) ((LAS unsigned*)(lds + LDSCTL_OFF))[u] = 0u;
    __syncthreads();
#if MK_ONE_LAUNCH
    XcdBarrier bar = xcd_barrier_post(ctl + CW_BAR, MISC + 8, wave);
#define GRID_BAR() xcd_barrier(bar)
#else
#define GRID_BAR() do {} while (0)
#endif
    const int lo = args.ph_lo, hi = args.ph_hi;
#ifndef PHASE_MASK
#define PHASE_MASK 0x7ff
#endif
#define IN(k) ((((PHASE_MASK) >> (k)) & 1) && lo <= (k) && (k) < hi)
#ifndef REPEAT_PHASE
#define REPEAT_PHASE -1
#endif
#ifndef REPEAT_MASK
#define REPEAT_MASK 0
#endif
#define REPQ(k) ((k) == REPEAT_PHASE || (((REPEAT_MASK) >> (k)) & 1))
#define REPS(k) for (int rep_ = 0; rep_ < (REPQ(k) ? 2 : 1); ++rep_, (REPQ(k) && rep_ == 1 ? (GRID_BAR(), 0) : 0))
#define SEAM(k) do { if (IN(k) && IN((k) + 1)) GRID_BAR(); } while (0)

    if (IN(0)) REPS(0) {
        LAS float* scr = (LAS float*)(lds + wave * 16384);
        constexpr int I_IN = (DM / 64) * (DIN / 32), I_UQ = (QL / 64) * (NQM / 32), I_UKV = (KVL / 64) * (NKV / 32), I_O = (DM / 64) * (DM / 32), I_UP = (DM / 64) * (NUP / 32), I_DN = (DFF / 64) * (DM / 32);
        constexpr int NITEMS = I_IN + I_UQ + I_UKV + I_O + I_UP + I_DN;
        for (int it = gw; it < NITEMS; it += NGW) {
            int r = it;
            if (r < I_IN) { p0_transpose_item<1>(w_in, DM, DIN, W1t, scr, r, lane); continue; } r -= I_IN;
            if (r < I_UQ) { p0_transpose_item<2>(w_uq, QL, NQM, Wuqt, scr, r, lane); continue; } r -= I_UQ;
            if (r < I_UKV) { p0_transpose_item<0>(w_ukv, KVL, NKV, Wukvt, scr, r, lane); continue; } r -= I_UKV;
            if (r < I_O) { p0_transpose_item<0>(w_o, DM, DM, Wot, scr, r, lane); continue; } r -= I_O;
            if (r < I_UP) { p0_transpose_item<3>(w_up, DM, NUP, Wupt, scr, r, lane); continue; } r -= I_UP;
            p0_transpose_item<0>(w_down, DFF, DM, Wdnt, scr, r, lane);
        }
        for (int m = gw; m < MR; m += NGW) {
            u32x2* o8 = (u32x2*)(NR + (size_t)m * DM) + lane;
            if (m >= MMAIN + NMETA) {
#pragma unroll
                for (int j = 0; j < 8; ++j) o8[64 * j] = (u32x2){0u, 0u};
                continue; }
            const float* row = m < MMAIN ? x + (size_t)m * DM : meta + (size_t)(m - MMAIN) * DM;
            f32x4 v[8]; const float ss = row_load(row, lane, v); const float rstd = rsqrtf(ss * (1.f / DM) + EPS);
#pragma unroll
            for (int j = 0; j < 8; ++j) { const f32x4 gg = *(const f32x4*)(g_attn_pre + 4 * lane + 256 * j);
                o8[64 * j] = (u32x2){pk2(v[j][0] * rstd * gg[0], v[j][1] * rstd * gg[1]), pk2(v[j][2] * rstd * gg[2], v[j][3] * rstd * gg[3])}; }
        }
        for (int it = gw; it < 4 * 16 * 48; it += NGW) { const int which = it / (16 * 48), r = it % (16 * 48), slot = r / 48, pos = LREAL + r % 48;
            bf16_t* base = which == 0 ? KD : which == 1 ? VD : which == 2 ? KM : VM; const int rb = (which == 2) ? 384 : 256;
            if (lane * 16 < rb) *(u32x4*)((char*)base + ((size_t)slot * LPB + pos) * rb + lane * 16) = (u32x4){0u, 0u, 0u, 0u}; }
        for (int e = bx * 512 + tid; e < LREAL * 32; e += G * 512) { const int pos = e >> 5, i = e & 31;
            const double inv = pow(10000.0, -(double)i / 32.0), ang = (double)pos * inv; CS[2 * e] = (float)cos(ang); CS[2 * e + 1] = (float)sin(ang); }
        for (int e = bx * 512 + tid; e < 8 * 512 + 8; e += G * 512) {
            if (e < 4096) { const int mp = e >> 9, d = 256 - (e & 511); BT[e] = (d >= 0 && d < 256) ? (rel_bias[t5_bucket(d) * 8 + mp] - rel_bias[31 * 8 + mp]) * LOG2E : 0.f; }
            else BT[e] = rel_bias[31 * 8 + (e - 4096)] * LOG2E; }
    }
    SEAM(0);
    if (IN(1)) REPS(1) {
        { SkinnyOut so{LAT, QD, KD, VD, DIFF_QSCALE, nullptr}; skinny16<0>(lds, NR + (size_t)MMAIN * DM, DM, W1t, DM, 244, G, bx, so, wave); }
        pg8::Gemm g{NR, W1t, DM, DM}; pg8::StaticOrder<0> S; S.init(MMAIN / 256, NP1 / 256, G, bx);
        pg8::EpiG1 E{LAT, QD, KD, VD, DIFF_QSCALE};
        pg8::gemm_phase<pg8::EpiG1, pg8::StaticOrder<0>, true>(lds, g, S, E, wave);
    }
    SEAM(1);
    if (IN(2)) REPS(2) {
        for (int m = gw; m < MMAIN + NMETA; m += NGW) {
            const bf16_t* row = LAT + (size_t)m * DLAT;
            { const u32x4 w = *(const u32x4*)(row + 8 * lane); float v[8]; float s = 0.f;
#pragma unroll
              for (int k = 0; k < 4; ++k) { v[2 * k] = bf2f(w[k]); v[2 * k + 1] = bf2f(w[k] >> 16); s += v[2 * k] * v[2 * k] + v[2 * k + 1] * v[2 * k + 1]; }
              const float rstd = rsqrtf(wave_sum(s) * (1.f / QL) + EPS); const f32x4 g0 = *(const f32x4*)(g_cq + 8 * lane), g1 = *(const f32x4*)(g_cq + 8 * lane + 4);
              u32x4 o; o.x = pk2(v[0] * rstd * g0[0], v[1] * rstd * g0[1]); o.y = pk2(v[2] * rstd * g0[2], v[3] * rstd * g0[3]); o.z = pk2(v[4] * rstd * g1[0], v[5] * rstd * g1[1]); o.w = pk2(v[6] * rstd * g1[2], v[7] * rstd * g1[3]);
              *(u32x4*)(CQN + (size_t)m * QL + 8 * lane) = o; }
            { const int l4 = lane & 31; const u32x4 w = *(const u32x4*)(row + QL + 8 * l4); float v[8]; float s = 0.f;
#pragma unroll
              for (int k = 0; k < 4; ++k) { v[2 * k] = bf2f(w[k]); v[2 * k + 1] = bf2f(w[k] >> 16); s += v[2 * k] * v[2 * k] + v[2 * k + 1] * v[2 * k + 1]; }
              if (lane >= 32) s = 0.f;
              const float rstd = rsqrtf(wave_sum(s) * (1.f / KVL) + EPS); const f32x4 g0 = *(const f32x4*)(g_ckv + 8 * l4), g1 = *(const f32x4*)(g_ckv + 8 * l4 + 4);
              u32x4 o; o.x = pk2(v[0] * rstd * g0[0], v[1] * rstd * g0[1]); o.y = pk2(v[2] * rstd * g0[2], v[3] * rstd * g0[3]); o.z = pk2(v[4] * rstd * g1[0], v[5] * rstd * g1[1]); o.w = pk2(v[6] * rstd * g1[2], v[7] * rstd * g1[3]);
              if (lane < 32) *(u32x4*)(CKVN + (size_t)m * KVL + 8 * l4) = o; }
            { const int i = lane & 31; const unsigned w = *(const unsigned*)(row + 768 + 2 * i); const float x1 = bf2f(w), x2 = bf2f(w >> 16);
              int b0, pos, nb; if (m < MMAIN) { b0 = m >> 12; pos = NMETA + (m & 4095); nb = 1; } else { b0 = 0; pos = m - MMAIN; nb = 2; }
              const f32x2 csv = *(const f32x2*)(CS + ((size_t)pos * 32 + i) * 2);
              const unsigned o = pk2(x1 * csv[0] - x2 * csv[1], x2 * csv[0] + x1 * csv[1]);
              for (int k = 0; k < nb; ++k)
#pragma unroll
                  for (int hh = 0; hh < 4; ++hh) { const int h = hh + 4 * (lane >> 5); *(unsigned*)(KM + ((size_t)((b0 + k) * 8 + h) * LPB + pos) * 192 + 128 + 2 * i) = o; } }
        }
    }
    SEAM(2);
    if (IN(3)) REPS(3) {
#ifndef G2_SEL
#define G2_SEL 3
#endif
        if (G2_SEL & 1) { pg8::Gemm g{CQN, Wuqt, QL, QL}; pg8::StaticOrder<0> S; S.init(MR / 256, NQM / 256, G, bx);
          pg8::EpiQm E{QM, CS, MLA_QSCALE};
          pg8::gemm_phase<pg8::EpiQm, pg8::StaticOrder<0>, true>(lds, g, S, E, wave); }
        if (G2_SEL & 2) { pg8::Gemm g{CKVN, Wukvt, KVL, KVL}; pg8::StaticOrder<0> S; S.init(MR / 256, NKV / 256, G, bx);
          pg8::EpiKv E{KM, VM};
          pg8::gemm_phase<pg8::EpiKv, pg8::StaticOrder<0>, true>(lds, g, S, E, wave); }
    }
    SEAM(3);
    if (IN(4)) REPS(4) {
        LAS char* al = (LAS char*)lds; volatile LAS int* uslot = (volatile LAS int*)(al + att::OFF_U);
        for (;;) {
            if (tid == 0) uslot[0] = (int)__hip_atomic_fetch_add(ctl + CW_QUEUE + 64 * rep_, 1u, RLX_AGENT);
            __syncthreads();
            const int u = __builtin_amdgcn_readfirstlane(uslot[0]);
            __syncthreads();
            if (u >= 17 * 48) break;
            const int qb = 16 - u / 48, rem = u % 48, b = rem / 24, vh = rem % 24;
            const int qpos0 = qb == 0 ? 0 : NMETA + 256 * (qb - 1), nrows = qb == 0 ? NMETA : 256, NT = qb == 0 ? 1 : 4 * qb + 1;
#ifndef ATT_SEL
#define ATT_SEL 3
#endif
            if (vh < 8) { if (ATT_SEL & 1) { const size_t hb = (size_t)(b * 8 + vh) * LPB;
                att::attn_unit<192, false>(QM + (hb + qpos0) * 192, KM + hb * 192, VM + hb * 128, b, qpos0, nrows, NT, nullptr, 0.f, CAT + vh * 128, DM, al, wave); }
            } else if (ATT_SEL & 2) { const int d = vh - 8, hc = d >> 1, vhalf = d & 1, h = d >> 2; const size_t hb = (size_t)(b * 8 + hc) * LPB;
                att::attn_unit<128, true>(QD + (hb + qpos0) * 128, KD + hb * 128, VD + (size_t)(b * 8 + h * 2 + vhalf) * LPB * 128, b, qpos0, nrows, NT, BT + hc * 512, BT[4096 + hc], DP + hc * 256 + vhalf * 128, DM, al, wave); }
        }
    }
    SEAM(4);
    if (IN(5)) REPS(5) {
        float lam;
        { const float a = wave_sum(lq1[lane] * lk1[lane] + lq1[lane + 64] * lk1[lane + 64]), c = wave_sum(lq2[lane] * lk2[lane] + lq2[lane + 64] * lk2[lane + 64]); lam = expf(a) - expf(c) + LAM_INIT; }
        const f32x4 gs = *(const f32x4*)(g_sub + 4 * lane);
        for (int it = gw; it < (MMAIN + NMETA) * 4; it += NGW) { const int m = it >> 2, h = it & 3;
            const u32x2 w0 = *(const u32x2*)(DP + (size_t)m * DM + (h * 2 + 0) * 256 + 4 * lane), w1 = *(const u32x2*)(DP + (size_t)m * DM + (h * 2 + 1) * 256 + 4 * lane);
            const f32x4 a0 = (f32x4){bf2f(w0[0]), bf2f(w0[0] >> 16), bf2f(w0[1]), bf2f(w0[1] >> 16)}, a1 = (f32x4){bf2f(w1[0]), bf2f(w1[0] >> 16), bf2f(w1[1]), bf2f(w1[1] >> 16)};
            const f32x4 dd = a0 - lam * a1; const float rstd = rsqrtf(wave_sum((dd[0] * dd[0] + dd[1] * dd[1]) + (dd[2] * dd[2] + dd[3] * dd[3])) * (1.f / 256.f) + EPS) * (1.f - LAM_INIT);
            *(u32x2*)(CAT + (size_t)m * DM + 1024 + 256 * h + 4 * lane) = (u32x2){pk2(dd[0] * rstd * gs[0], dd[1] * rstd * gs[1]), pk2(dd[2] * rstd * gs[2], dd[3] * rstd * gs[3])}; }
    }
    SEAM(5);
    if (IN(6)) REPS(6) {
        { SkinnyOut so{nullptr, nullptr, nullptr, nullptr, 1.f, AO}; skinny16<1>(lds, CAT + (size_t)MMAIN * DM, DM, Wot, DM, 128, G, bx, so, wave); }
        pg8::Gemm g{CAT, Wot, DM, DM}; pg8::StaticOrder<0> S; S.init(MMAIN / 256, DM / 256, G, bx);
        pg8::EpiB16 E{AO, DM};
        pg8::gemm_phase<pg8::EpiB16, pg8::StaticOrder<0>, true>(lds, g, S, E, wave);
    }
    SEAM(6);
    if (IN(7)) REPS(7) {
        for (int m = gw; m < MMAIN + NMETA; m += NGW) {
            f32x4 a[8]; const float sa = row_load_bf16(AO + (size_t)m * DM, lane, a); const float rs1 = rsqrtf(sa * (1.f / DM) + EPS);
            const float* row0 = m < MMAIN ? x + (size_t)m * DM : meta + (size_t)(m - MMAIN) * DM; float s2 = 0.f;
#pragma unroll
            for (int j = 0; j < 8; ++j) { const f32x4 gg = *(const f32x4*)(g_attn_post + 4 * lane + 256 * j), h0 = *(const f32x4*)(row0 + 4 * lane + 256 * j);
                a[j] = h0 + a[j] * rs1 * gg; s2 += (a[j][0] * a[j][0] + a[j][1] * a[j][1]) + (a[j][2] * a[j][2] + a[j][3] * a[j][3]);
                *(f32x4*)(HB + (size_t)m * DM + 4 * lane + 256 * j) = a[j]; }
            const float rs2 = rsqrtf(wave_sum(s2) * (1.f / DM) + EPS);
            int b0, pos, nb; if (m < MMAIN) { b0 = m >> 12; pos = NMETA + (m & 4095); nb = 1; } else { b0 = 0; pos = m - MMAIN; nb = 2; }
#pragma unroll
            for (int j = 0; j < 8; ++j) { const f32x4 gg = *(const f32x4*)(g_ffn_pre + 4 * lane + 256 * j);
                const u32x2 o = (u32x2){pk2(a[j][0] * rs2 * gg[0], a[j][1] * rs2 * gg[1]), pk2(a[j][2] * rs2 * gg[2], a[j][3] * rs2 * gg[3])};
                for (int k = 0; k < nb; ++k) *(u32x2*)(N2 + ((size_t)(b0 + k) * LPB + pos) * DM + 4 * lane + 256 * j) = o; }
        }
    }
    SEAM(7);
    if (IN(8)) REPS(8) {
        pg8::Gemm g{N2, Wupt, DM, DM}; pg8::StaticOrder<1> S; S.init(34, NUP / 256, G, bx);
        pg8::EpiConv E{ACT, conv_w, conv_b, (LAS float*)(lds + XCONV_OFF)};
        pg8::gemm_phase<pg8::EpiConv, pg8::StaticOrder<1>, true>(lds, g, S, E, wave);
    }
    SEAM(8);
    if (IN(9)) REPS(9) {
        pg8::Gemm g{ACT, Wdnt, DFF, DFF}; pg8::StaticOrder<0> S; S.init(MMAIN / 256, DM / 256, G, bx);
        pg8::EpiB16 E{FB, DM};
        pg8::gemm_phase<pg8::EpiB16, pg8::StaticOrder<0>, true>(lds, g, S, E, wave);
    }
    SEAM(9);
    if (IN(10)) REPS(10) {
        for (int m = gw; m < MMAIN; m += NGW) {
            f32x4 a[8]; const float sa = row_load_bf16(FB + (size_t)m * DM, lane, a); const float rs = rsqrtf(sa * (1.f / DM) + EPS);
#pragma unroll
            for (int j = 0; j < 8; ++j) { const f32x4 gg = *(const f32x4*)(g_ffn_post + 4 * lane + 256 * j), hh = *(const f32x4*)(HB + (size_t)m * DM + 4 * lane + 256 * j);
                *(f32x4*)(args.out + (size_t)m * DM + 4 * lane + 256 * j) = hh + a[j] * rs * gg; }
        }
    }
#undef IN
#undef SEAM
#undef tid
#undef lane
}

#if DEBUG_CHECK
__device__ __forceinline__ unsigned hash_u(unsigned a) { a ^= a >> 16; a *= 0x7feb352du; a ^= a >> 15; a *= 0x846ca68bu; a ^= a >> 16; return a; }
__device__ __forceinline__ float bfr(float v) { return bf2f(f2bf(v)); }
__device__ __forceinline__ void chk_rec(unsigned* chk, int stage, float got, float want, float rtol, float atol) {
    float ratio = fabsf(got - want) / (atol + rtol * fabsf(want)); if (!(ratio == ratio)) ratio = 1e30f;
    atomicMax(chk + stage, __float_as_uint(ratio));
}
struct CArgs { const float* in[22]; float* out; unsigned char* ws; };
__global__ void __launch_bounds__(64) chk_kernel(CArgs a, int stage, int nsamp) {
    const int lane = threadIdx.x; unsigned char* ws = a.ws; unsigned* chk = (unsigned*)(ws + WS_CHK);
    const float* x = a.in[0]; const float* meta = a.in[1]; const float* rel_bias = a.in[2]; const float* w_in = a.in[3]; const float* w_uq = a.in[4]; const float* w_ukv = a.in[5]; const float* w_o = a.in[6];
    const float* g_attn_pre = a.in[7]; const float* g_attn_post = a.in[8]; const float* g_cq = a.in[9]; const float* g_ckv = a.in[10];
    const float* g_sub = a.in[15]; const float* g_ffn_pre = a.in[16]; const float* w_up = a.in[18]; const float* conv_w = a.in[19]; const float* conv_b = a.in[20]; const float* w_down = a.in[21];
    const float* CS = (const float*)(ws + WS_CS);
    const bf16_t* NR = (const bf16_t*)(ws + WS_NR); const bf16_t* LAT = (const bf16_t*)(ws + WS_LAT); const bf16_t* CQN = (const bf16_t*)(ws + WS_CQN); const bf16_t* CKVN = (const bf16_t*)(ws + WS_CKVN);
    const bf16_t* QD = (const bf16_t*)(ws + WS_QD); const bf16_t* KD = (const bf16_t*)(ws + WS_KD); const bf16_t* VD = (const bf16_t*)(ws + WS_VD);
    const bf16_t* QM = (const bf16_t*)(ws + WS_QM); const bf16_t* KM = (const bf16_t*)(ws + WS_KM); const bf16_t* VM = (const bf16_t*)(ws + WS_VM);
    const bf16_t* CAT = (const bf16_t*)(ws + WS_CAT); const bf16_t* DPb = (const bf16_t*)(ws + WS_DP); const bf16_t* AOb = (const bf16_t*)(ws + WS_AO); const float* HB = (const float*)(ws + WS_H);
#define DP(i) bf2f(DPb[i])
#define AO(i) bf2f(AOb[i])
#define FB(i) bf2f(FBb[i])
    const bf16_t* N2 = (const bf16_t*)(ws + WS_N2); const bf16_t* ACT = (const bf16_t*)(ws + WS_ACT); const bf16_t* FBb = (const bf16_t*)(ws + WS_F);
    __shared__ float pbuf[LREAL + 64];
    const int s = blockIdx.x; const unsigned h0 = hash_u(s * 2654435761u + stage * 97u), h1 = hash_u(h0 + 12345u), h2 = hash_u(h1 + 777u);
    int m = (s % 8 == 0) ? MMAIN + (h0 % NMETA) : (int)(h0 % MMAIN);
    if (s % 8 == 1) m = (h0 & 1) * SEQ + (h1 % 4);
    if (s % 8 == 2) m = (h0 & 1) * SEQ + SEQ - 1 - (h1 % 4);
    int b, pos; if (m < MMAIN) { b = m >> 12; pos = NMETA + (m & 4095); } else { b = h2 & 1; pos = m - MMAIN; }
    const float* row0 = m < MMAIN ? x + (size_t)m * DM : meta + (size_t)(m - MMAIN) * DM;
    if (stage == 1) {
        float ss = 0.f; for (int k = lane; k < DM; k += 64) ss += row0[k] * row0[k]; ss = wave_sum(ss); const float rstd = rsqrtf(ss / DM + EPS);
        const int c = h1 % DM; if (lane == 0) chk_rec(chk, 1, bf2f(NR[(size_t)m * DM + c]), row0[c] * rstd * g_attn_pre[c], 1e-2f, 1e-3f);
        if (lane == 1) { const int mz = MMAIN + NMETA + (h1 % (MR - MMAIN - NMETA)); chk_rec(chk, 1, bf2f(NR[(size_t)mz * DM + c]), 0.f, 1e-2f, 1e-6f); }
    } else if (stage == 2) {
        const int n = h1 % DIN; float d = 0.f; for (int k = lane; k < DM; k += 64) d += bf2f(NR[(size_t)m * DM + k]) * bfr(w_in[(size_t)k * DIN + n]); d = wave_sum(d);
        float got;
        if (n < 832) { got = bf2f(LAT[(size_t)m * DLAT + map_win(n)]); }
        else { const int r = n - 832, typ = r >> 10, hc = (r & 1023) >> 7, col = r & 127; const bf16_t* base = typ == 0 ? QD : typ == 1 ? KD : VD; if (typ == 0) d *= DIFF_QSCALE;
            got = bf2f(base[((size_t)(b * 8 + hc) * LPB + pos) * 128 + col]); }
        if (lane == 0) chk_rec(chk, 2, got, d, 2e-2f, 2e-2f);
    } else if (stage == 3) {
        float ss = 0.f; for (int k = lane; k < QL; k += 64) { const float v = bf2f(LAT[(size_t)m * DLAT + k]); ss += v * v; } ss = wave_sum(ss);
        float s2 = 0.f; for (int k = lane; k < KVL; k += 64) { const float v = bf2f(LAT[(size_t)m * DLAT + QL + k]); s2 += v * v; } s2 = wave_sum(s2);
        const int c = h1 % QL, c2 = h1 % KVL, i = h2 % 32, hh = (h2 >> 8) % 8;
        if (lane == 0) chk_rec(chk, 3, bf2f(CQN[(size_t)m * QL + c]), bf2f(LAT[(size_t)m * DLAT + c]) * rsqrtf(ss / QL + EPS) * g_cq[c], 1e-2f, 1e-3f);
        if (lane == 1) chk_rec(chk, 3, bf2f(CKVN[(size_t)m * KVL + c2]), bf2f(LAT[(size_t)m * DLAT + QL + c2]) * rsqrtf(s2 / KVL + EPS) * g_ckv[c2], 1e-2f, 1e-3f);
        if (lane == 2) { const float x1 = bf2f(LAT[(size_t)m * DLAT + 768 + 2 * i]), x2 = bf2f(LAT[(size_t)m * DLAT + 768 + 2 * i + 1]);
            const double inv = pow(10000.0, -(double)i / 32.0), ang = pos * inv; const float cc = (float)cos(ang), sn = (float)sin(ang);
            const bf16_t* kr = KM + ((size_t)(b * 8 + hh) * LPB + pos) * 192 + 128 + 2 * i;
            chk_rec(chk, 3, bf2f(kr[0]), x1 * cc - x2 * sn, 1e-2f, 2e-3f); chk_rec(chk, 3, bf2f(kr[1]), x2 * cc + x1 * sn, 1e-2f, 2e-3f); }
    } else if (stage == 4) {
        const int h = h1 % 8;
        { const int d = h2 % 128; float q = 0.f; for (int k = lane; k < QL; k += 64) q += bf2f(CQN[(size_t)m * QL + k]) * bfr(w_uq[(size_t)k * NQM + h * 192 + d]); q = wave_sum(q);
          if (lane == 0) chk_rec(chk, 4, bf2f(QM[((size_t)(b * 8 + h) * LPB + pos) * 192 + d]), q * MLA_QSCALE, 2e-2f, 1e-2f); }
        { const int i = (h2 >> 8) % 32; float q1 = 0.f, q2 = 0.f; for (int k = lane; k < QL; k += 64) { const float c = bf2f(CQN[(size_t)m * QL + k]); q1 += c * bfr(w_uq[(size_t)k * NQM + h * 192 + 128 + i]); q2 += c * bfr(w_uq[(size_t)k * NQM + h * 192 + 160 + i]); }
          q1 = wave_sum(q1); q2 = wave_sum(q2); const double inv = pow(10000.0, -(double)i / 32.0), ang = pos * inv; const float cc = (float)cos(ang), sn = (float)sin(ang);
          const bf16_t* qp = QM + ((size_t)(b * 8 + h) * LPB + pos) * 192 + 128 + 2 * i;
          if (lane == 0) { chk_rec(chk, 4, bf2f(qp[0]), (q1 * cc - q2 * sn) * MLA_QSCALE, 2e-2f, 1e-2f); chk_rec(chk, 4, bf2f(qp[1]), (q2 * cc + q1 * sn) * MLA_QSCALE, 2e-2f, 1e-2f); } }
        { const int d = (h2 >> 16) % 256; float kv = 0.f; for (int k = lane; k < KVL; k += 64) kv += bf2f(CKVN[(size_t)m * KVL + k]) * bfr(w_ukv[(size_t)k * NKV + h * 256 + d]); kv = wave_sum(kv);
          const float got = d < 128 ? bf2f(KM[((size_t)(b * 8 + h) * LPB + pos) * 192 + d]) : bf2f(VM[((size_t)(b * 8 + h) * LPB + pos) * 128 + d - 128]);
          if (lane == 0) chk_rec(chk, 4, got, kv, 2e-2f, 2e-2f); }
    } else if (stage == 5 || stage == 6) {
        if (m >= MMAIN) b = 0;
        const bool diff = stage == 6; const int dqk = diff ? 128 : 192; const int hx = h1 % 8;
        const bf16_t* Q = diff ? QD + ((size_t)(b * 8 + hx) * LPB + pos) * 128 : QM + ((size_t)(b * 8 + hx) * LPB + pos) * 192;
        const bf16_t* K = diff ? KD + (size_t)(b * 8 + hx) * LPB * 128 : KM + (size_t)(b * 8 + hx) * LPB * 192;
        float mx = -INFINITY;
        for (int k = lane; k <= pos; k += 64) { float sc = 0.f; for (int d = 0; d < dqk; ++d) sc += bf2f(Q[d]) * bf2f(K[(size_t)k * dqk + d]);
            if (diff) { const int n = pos - k; int bk = n; if (n >= 16) { bk = 16 + (int)(logf((float)n / 16.f) / logf(8.f) * 16.f); if (bk > 31) bk = 31; } sc += rel_bias[bk * 8 + hx] * LOG2E; }
            pbuf[k] = sc; mx = fmaxf(mx, sc); }
        mx = wave_max(mx); float l = 0.f;
        for (int k = lane; k <= pos; k += 64) { const float p = exp2f(pbuf[k] - mx); pbuf[k] = p; l += p; } l = wave_sum(l); __syncthreads();
        if (!diff) { const bf16_t* V = VM + (size_t)(b * 8 + hx) * LPB * 128;
            for (int c = lane; c < 128; c += 64) { float o = 0.f; for (int k = 0; k <= pos; ++k) o += pbuf[k] * bf2f(V[(size_t)k * 128 + c]); o /= l;
                { const float got = bf2f(CAT[(size_t)m * DM + hx * 128 + c]); chk_rec(chk, m >= MMAIN ? 12 : 5, got, o, 3e-2f, 5e-3f); if (!(fabsf(got) < 1e30f)) atomicMax(chk + 14, 0x7f000000u); if (m < MMAIN) chk_rec(chk, 16, got, o, 1.5f, 0.25f); } } }
        else { const int hd = hx >> 1;
            for (int c = lane; c < 256; c += 64) { const bf16_t* V = VD + (size_t)(b * 8 + hd * 2 + (c >> 7)) * LPB * 128; float o = 0.f; for (int k = 0; k <= pos; ++k) o += pbuf[k] * bf2f(V[(size_t)k * 128 + (c & 127)]); o /= l;
                { const float got = DP((size_t)m * DM + hx * 256 + c); chk_rec(chk, m >= MMAIN ? 13 : 6, got, o, 3e-2f, 5e-3f); if (!(fabsf(got) < 1e30f)) atomicMax(chk + 15, 0x7f000000u); if (m < MMAIN) chk_rec(chk, 17, got, o, 1.5f, 0.25f); } } }
    } else if (stage == 7) {
        const float* lq1 = a.in[11]; const float* lk1 = a.in[12]; const float* lq2 = a.in[13]; const float* lk2 = a.in[14];
        float s1 = 0.f, s2 = 0.f; for (int k = lane; k < 128; k += 64) { s1 += lq1[k] * lk1[k]; s2 += lq2[k] * lk2[k]; } s1 = wave_sum(s1); s2 = wave_sum(s2); const float lam = expf(s1) - expf(s2) + LAM_INIT;
        const int h = h1 % 4; float ss = 0.f; for (int c = lane; c < 256; c += 64) { const float d = DP((size_t)m * DM + (h * 2) * 256 + c) - lam * DP((size_t)m * DM + (h * 2 + 1) * 256 + c); ss += d * d; } ss = wave_sum(ss);
        const int c = h2 % 256; const float d = DP((size_t)m * DM + (h * 2) * 256 + c) - lam * DP((size_t)m * DM + (h * 2 + 1) * 256 + c);
        if (lane == 0) chk_rec(chk, 7, bf2f(CAT[(size_t)m * DM + 1024 + h * 256 + c]), d * rsqrtf(ss / 256.f + EPS) * g_sub[c] * 0.8f, 1e-2f, 1e-3f);
    } else if (stage == 8) {
        const int n = h1 % DM; float d = 0.f; for (int k = lane; k < DM; k += 64) d += bf2f(CAT[(size_t)m * DM + k]) * bfr(w_o[(size_t)k * DM + n]); d = wave_sum(d);
        if (lane == 0) chk_rec(chk, 8, AO((size_t)m * DM + n), d, 2e-2f, 2e-2f);
    } else if (stage == 9) {
        float ss = 0.f; for (int k = lane; k < DM; k += 64) { const float v = AO((size_t)m * DM + k); ss += v * v; } ss = wave_sum(ss); const float rs1 = rsqrtf(ss / DM + EPS);
        float s2 = 0.f; for (int k = lane; k < DM; k += 64) { const float hv = row0[k] + AO((size_t)m * DM + k) * rs1 * g_attn_post[k]; s2 += hv * hv; } s2 = wave_sum(s2); const float rs2 = rsqrtf(s2 / DM + EPS);
        const int c = h1 % DM; const float hv = row0[c] + AO((size_t)m * DM + c) * rs1 * g_attn_post[c];
        if (lane == 0) { chk_rec(chk, 9, HB[(size_t)m * DM + c], hv, 1e-4f, 1e-4f); chk_rec(chk, 9, bf2f(N2[((size_t)b * LPB + pos) * DM + c]), hv * rs2 * g_ffn_pre[c], 1e-2f, 1e-3f); }
    } else if (stage == 10) {
        if (m >= MMAIN) { m = h0 % MMAIN; b = m >> 12; pos = NMETA + (m & 4095); }
        const int c = h1 % DFF; float up[2][3];
        for (int gv = 0; gv < 2; ++gv) for (int j = 0; j < 3; ++j) { const int col = gv * DFF + c; const bf16_t* nr = N2 + ((size_t)b * LPB + pos - 2 + j) * DM; float d = 0.f;
            for (int k = lane; k < DM; k += 64) d += bf2f(nr[k]) * bfr(w_up[(size_t)k * NUP + col]); up[gv][j] = wave_sum(d); }
        float cv[2]; for (int gv = 0; gv < 2; ++gv) { const int col = gv * DFF + c; cv[gv] = conv_b[col] + conv_w[col] * up[gv][0] + conv_w[NUP + col] * up[gv][1] + conv_w[2 * NUP + col] * up[gv][2]; }
        const float want = cv[0] / (1.f + expf(-cv[0])) * cv[1];
        if (lane == 0) chk_rec(chk, 10, bf2f(ACT[(size_t)m * DFF + c]), want, 3e-2f, 3e-2f);
    } else if (stage == 11) {
        if (m >= MMAIN) m = h0 % MMAIN;
        const int n = h1 % DM; float d = 0.f; for (int k = lane; k < DFF; k += 64) d += bf2f(ACT[(size_t)m * DFF + k]) * bfr(w_down[(size_t)k * DM + n]); d = wave_sum(d);
        if (lane == 0) chk_rec(chk, 11, FB((size_t)m * DM + n), d, 2e-2f, 2e-2f);
    }
}
#undef DP
#undef AO
#undef FB
__global__ void __launch_bounds__(64) naive_attn(CArgs a) {
    const int lane = threadIdx.x; unsigned char* ws = a.ws; const float* rel_bias = a.in[2];
    const bf16_t* QD = (const bf16_t*)(ws + WS_QD); const bf16_t* KD = (const bf16_t*)(ws + WS_KD); const bf16_t* VD = (const bf16_t*)(ws + WS_VD);
    const bf16_t* QM = (const bf16_t*)(ws + WS_QM); const bf16_t* KM = (const bf16_t*)(ws + WS_KM); const bf16_t* VM = (const bf16_t*)(ws + WS_VM);
    bf16_t* CAT = (bf16_t*)(ws + WS_CAT); bf16_t* DP = (bf16_t*)(ws + WS_DP);
    __shared__ float pbuf[LREAL + 64];
    const int m = blockIdx.x / 16, task = blockIdx.x % 16; const bool diff = task >= 8; const int hx = task & 7, dqk = diff ? 128 : 192;
    int b, pos; if (m < MMAIN) { b = m >> 12; pos = NMETA + (m & 4095); } else { b = 0; pos = m - MMAIN; }
    const bf16_t* Q = diff ? QD + ((size_t)(b * 8 + hx) * LPB + pos) * 128 : QM + ((size_t)(b * 8 + hx) * LPB + pos) * 192;
    const bf16_t* K = diff ? KD + (size_t)(b * 8 + hx) * LPB * 128 : KM + (size_t)(b * 8 + hx) * LPB * 192;
    float mx = -INFINITY;
    for (int k = lane; k <= pos; k += 64) { float sc = 0.f; for (int d = 0; d < dqk; ++d) sc += bf2f(Q[d]) * bf2f(K[(size_t)k * dqk + d]);
        if (diff) { const int n = pos - k; int bk = n; if (n >= 16) { bk = 16 + (int)(logf((float)n / 16.f) / logf(8.f) * 16.f); if (bk > 31) bk = 31; } sc += rel_bias[bk * 8 + hx] * LOG2E; }
        pbuf[k] = sc; mx = fmaxf(mx, sc); }
    mx = wave_max(mx); float l = 0.f;
    for (int k = lane; k <= pos; k += 64) { const float p = exp2f(pbuf[k] - mx); pbuf[k] = p; l += p; } l = wave_sum(l); __syncthreads();
    if (!diff) { const bf16_t* V = VM + (size_t)(b * 8 + hx) * LPB * 128;
        for (int c = lane; c < 128; c += 64) { float o = 0.f; for (int k = 0; k <= pos; ++k) o += pbuf[k] * bf2f(V[(size_t)k * 128 + c]); CAT[(size_t)m * DM + hx * 128 + c] = (bf16_t)f2bf(o / l); } }
    else { const int hd = hx >> 1;
        for (int c = lane; c < 256; c += 64) { const bf16_t* V = VD + (size_t)(b * 8 + hd * 2 + (c >> 7)) * LPB * 128; float o = 0.f; for (int k = 0; k <= pos; ++k) o += pbuf[k] * bf2f(V[(size_t)k * 128 + (c & 127)]); DP[(size_t)m * DM + hx * 256 + c] = (bf16_t)f2bf(o / l); } }
}
__global__ void __launch_bounds__(256) chk_poison(float* out, int n, const unsigned* chk) {
    int first = 0, mask = 0;
    for (int k = 1; k <= 13; ++k) if (k != 5 && k != 6 && __uint_as_float(chk[k]) > 1.f && first == 0) first = k;
    const int ids[6] = {5, 6, 14, 15, 16, 17};
    for (int i = 0; i < 6; ++i) if (__uint_as_float(chk[ids[i]]) > 1.f) mask |= 1 << i;
    if (first == 0 && mask == 0) return;
    const float c = sqrtf(3.f * exp2f((float)first));
    for (int i = blockIdx.x * 256 + threadIdx.x; i < n; i += gridDim.x * 256) { if (i == 12345) { if (mask) out[i] = 100.f + 10.f * mask; } else if (first) out[i] = c; }
}
#endif

extern "C" void kernel_launch(void* const* d_in, const int* in_sizes, int n_in, void* d_out, int out_size, void* d_ws, size_t ws_size, hipStream_t stream) {
    static int grid = 0;
    if (grid == 0) {
        if (n_in != 22 || in_sizes[0] != MMAIN * DM || out_size != MMAIN * DM || ws_size < WS_END) {
            fprintf(stderr, "kernel_launch: unexpected shapes: n_in %d in0 %d out %d ws %zu (need %zu)\n", n_in, n_in > 0 ? in_sizes[0] : -1, out_size, ws_size, (size_t)WS_END); grid = -1; return; }
        int dev = 0, cus = 0;
        if (hipGetDevice(&dev) != hipSuccess || hipDeviceGetAttribute(&cus, hipDeviceAttributeMultiprocessorCount, dev) != hipSuccess) { grid = -1; return; }
        if (hipFuncSetAttribute((const void*)hymba_fwd, hipFuncAttributeMaxDynamicSharedMemorySize, LDS_BYTES) != hipSuccess) { fprintf(stderr, "kernel_launch: hipFuncSetAttribute failed\n"); grid = -1; return; }
        int per_cu = 0; (void)hipOccupancyMaxActiveBlocksPerMultiprocessor(&per_cu, (const void*)hymba_fwd, 512, LDS_BYTES); (void)hipGetLastError();
        grid = cus;
    }
    if (grid < 0) return;
    (void)hipMemsetAsync((char*)d_ws + WS_CTL, 0, CTL_ZERO_BYTES, stream);
    Args a{};
    for (int i = 0; i < 22; ++i) a.in[i] = (const float*)d_in[i];
    a.out = (float*)d_out; a.ws = (unsigned char*)d_ws;
#if !DEBUG_CHECK
#if MK_ONE_LAUNCH
    a.ph_lo = 0; a.ph_hi = 11;
    hipLaunchKernelGGL(hymba_fwd, dim3(grid), dim3(512), LDS_BYTES, stream, a);
#else
    for (int p = 0; p < 11; ++p) { a.ph_lo = p; a.ph_hi = p + 1; hipLaunchKernelGGL(hymba_fwd, dim3(grid), dim3(512), LDS_BYTES, stream, a); }
#endif
#else
    CArgs c{}; for (int i = 0; i < 22; ++i) c.in[i] = (const float*)d_in[i]; c.out = (float*)d_out; c.ws = (unsigned char*)d_ws;
    static const int stage_after_phase[12] = {0, 0, 1, 2, 3, 4, 4, 5, 6, 7, 8, 9};
    int done = -1;
    for (int k = 1; k <= 11; ++k) {
        for (int p = done + 1; p <= stage_after_phase[k]; ++p) { a.ph_lo = p; a.ph_hi = p + 1; hipLaunchKernelGGL(hymba_fwd, dim3(grid), dim3(512), LDS_BYTES, stream, a); }
        if (stage_after_phase[k] > done) done = stage_after_phase[k];
        hipLaunchKernelGGL(chk_kernel, dim3(k == 5 || k == 6 ? 192 : 768), dim3(64), 0, stream, c, k, 0);
        if (k == 6) hipLaunchKernelGGL(naive_attn, dim3((MMAIN + NMETA) * 16), dim3(64), 0, stream, c);
    }
    a.ph_lo = 10; a.ph_hi = 11; hipLaunchKernelGGL(hymba_fwd, dim3(grid), dim3(512), LDS_BYTES, stream, a);
    hipLaunchKernelGGL(chk_poison, dim3(1024), dim3(256), 0, stream, (float*)d_out, out_size, (const unsigned*)((char*)d_ws + WS_CHK));
#endif
    const hipError_t le = hipPeekAtLastError();
    if (le != hipSuccess) fprintf(stderr, "kernel_launch: launch failed: %s\n", hipGetErrorName(le));
}
```
